# Optimizing an MI355X kernel written in HIP

```python
import jax, jax.numpy as jnp
from jax import lax
import numpy as np

D_MODEL = 2048
BATCH = 8
SEQ = 4096
DEPTH = 2

N_MIXERS = 2
HG_HEADS = 16
HG_KEY_DIM = 128
HG_VAL_DIM = D_MODEL // HG_HEADS
HG_WIDTH = HG_HEADS * HG_KEY_DIM
HG_V_WIDTH = HG_HEADS * HG_VAL_DIM
HG_CHUNK = 64
SG_WIDTH = D_MODEL
SG_GROUPS = 16
SG_GROUP_DIM = SG_WIDTH // SG_GROUPS
SG_CHUNK = 128
D_FF = 5632
CONV_WIDTH = 3
ALPHA = (2 * DEPTH) ** 0.25
BETA = (8 * DEPTH) ** -0.25
LN_EPS = 1e-5
RMS_EPS = 1e-6
N_HG_LAYERS = (DEPTH + 1) // 2
N_SG_LAYERS = DEPTH // 2

kernel_name = 'hgrn2_gmlp_convffn_deepnorm_hybrid'


def layer_norm(x, g, b):
    xf = x.astype(jnp.float32)
    mu = jnp.mean(xf, axis=-1, keepdims=True)
    xc = xf - mu
    var = jnp.mean(xc * xc, axis=-1, keepdims=True)
    y = xc * lax.rsqrt(var + LN_EPS) * g.astype(jnp.float32) + b.astype(jnp.float32)
    return y.astype(x.dtype)


def hgrn2_mixer(x, w_in, norm_g, w_out, lb):
    b_, s_, _ = x.shape
    n = s_ // HG_CHUNK
    proj = x @ w_in
    q, f, i, g = jnp.split(proj, [HG_WIDTH, 2 * HG_WIDTH, 2 * HG_WIDTH + HG_V_WIDTH], axis=-1)
    f = f.astype(jnp.float32)
    q = jax.nn.silu(q.astype(jnp.float32))
    v = i.astype(jnp.float32)
    log_forget = jnp.logaddexp(jnp.log(lb), jnp.log1p(-lb) + jax.nn.log_sigmoid(f))
    k = (1.0 - lb) * jax.nn.sigmoid(-f)

    def to_chunks(t, d):
        return t.reshape(b_, n, HG_CHUNK, HG_HEADS, d).transpose(1, 0, 3, 2, 4)

    qc = to_chunks(q, HG_KEY_DIM)
    kc = to_chunks(k, HG_KEY_DIM)
    lfc = to_chunks(log_forget, HG_KEY_DIM)
    vc = to_chunks(v, HG_VAL_DIM)
    mask = jnp.tril(jnp.ones((HG_CHUNK, HG_CHUNK), dtype=bool))

    def step(state, inp):
        q_c, k_c, v_c, lf_c = inp
        cum = jnp.cumsum(lf_c, axis=2)
        rel = cum[:, :, :, None, :] - cum[:, :, None, :, :]
        decay = jnp.exp(jnp.where(mask[:, :, None], rel, -jnp.inf))
        scores = jnp.einsum('bhtk,bhsk,bhtsk->bhts', q_c, k_c, decay)
        out = (jnp.einsum('bhts,bhsv->bhtv', scores, v_c)
               + jnp.einsum('bhtk,bhkv->bhtv', q_c * jnp.exp(cum), state))
        last = cum[:, :, -1:, :]
        new_state = (jnp.exp(last[:, :, 0, :, None]) * state
                     + jnp.einsum('bhsk,bhsv->bhkv', k_c * jnp.exp(last - cum), v_c))
        return new_state, out

    state0 = jnp.zeros((b_, HG_HEADS, HG_KEY_DIM, HG_VAL_DIM), jnp.float32)
    _, o = lax.scan(step, state0, (qc, kc, vc, lfc))
    o = o.transpose(1, 0, 3, 2, 4).reshape(b_, s_, HG_HEADS, HG_VAL_DIM)
    o = o * lax.rsqrt(jnp.mean(o * o, axis=-1, keepdims=True) + RMS_EPS)
    o = o * norm_g.astype(jnp.float32).reshape(HG_HEADS, HG_VAL_DIM)
    o = o.reshape(b_, s_, HG_V_WIDTH) * jax.nn.silu(g.astype(jnp.float32))
    return o.astype(x.dtype) @ w_out


def chunked_gmlp(x, w_in, ln_g, ln_b, w_s, b_s, w_out):
    b_, s_, _ = x.shape
    n = s_ // SG_CHUNK
    z = jax.nn.gelu(x @ w_in, approximate=False)
    u, v = jnp.split(z, 2, axis=-1)
    v = layer_norm(v, ln_g, ln_b).reshape(b_, n, SG_CHUNK, SG_GROUPS, SG_GROUP_DIM)
    w_causal = w_s * jnp.tril(jnp.ones((SG_CHUNK, SG_CHUNK), w_s.dtype))
    gate = jnp.einsum('gts,bnsgc->bntgc', w_causal, v) + b_s.T[:, :, None]
    y = u * gate.reshape(b_, s_, SG_WIDTH)
    return y @ w_out


def conv_ffn(x, w_up, conv_w, conv_b, w_down):
    s_ = x.shape[1]
    h = x @ w_up
    a, b = jnp.split(h, 2, axis=-1)
    a_pad = jnp.pad(a, ((0, 0), (CONV_WIDTH - 1, 0), (0, 0)))
    a = sum(conv_w[j] * a_pad[:, j:j + s_] for j in range(CONV_WIDTH)) + conv_b
    return (jax.nn.silu(a) * b) @ w_down


def setup_inputs(seed: int = 0) -> dict:
    key = jax.random.key(seed)
    ks = jax.random.split(key, 24)
    nrm = jax.random.normal
    f32 = jnp.float32
    d = D_MODEL
    hg_in_cols = 2 * HG_WIDTH + 2 * HG_V_WIDTH
    return {
        'x': nrm(ks[0], (BATCH, SEQ, d), f32),
        'lb_logits': 0.5 * nrm(ks[1], (DEPTH + 1, HG_WIDTH), f32),
        'hg_w_in': nrm(ks[2], (N_HG_LAYERS, d, hg_in_cols), f32) * d ** -0.5,
        'hg_norm_g': 1.0 + 0.02 * nrm(ks[3], (N_HG_LAYERS, HG_V_WIDTH), f32),
        'hg_w_out': nrm(ks[4], (N_HG_LAYERS, HG_V_WIDTH, d), f32) * HG_V_WIDTH ** -0.5 * BETA,
        'sg_w_in': nrm(ks[5], (N_SG_LAYERS, d, 2 * SG_WIDTH), f32) * d ** -0.5,
        'sg_ln_g': 1.0 + 0.02 * nrm(ks[6], (N_SG_LAYERS, SG_WIDTH), f32),
        'sg_ln_b': 0.02 * nrm(ks[7], (N_SG_LAYERS, SG_WIDTH), f32),
        'sg_w_s': nrm(ks[8], (N_SG_LAYERS, SG_GROUPS, SG_CHUNK, SG_CHUNK), f32) * 0.5 * SG_CHUNK ** -0.5,
        'sg_b_s': 1.0 + 0.1 * nrm(ks[9], (N_SG_LAYERS, SG_GROUPS, SG_CHUNK), f32),
        'sg_w_out': nrm(ks[10], (N_SG_LAYERS, SG_WIDTH, d), f32) * SG_WIDTH ** -0.5 * BETA,
        'ffn_w_up': nrm(ks[11], (DEPTH, d, 2 * D_FF), f32) * d ** -0.5,
        'ffn_conv_w': nrm(ks[12], (DEPTH, CONV_WIDTH, D_FF), f32) * CONV_WIDTH ** -0.5,
        'ffn_conv_b': 0.02 * nrm(ks[13], (DEPTH, D_FF), f32),
        'ffn_w_down': nrm(ks[14], (DEPTH, D_FF, d), f32) * D_FF ** -0.5 * BETA,
        'ln1_g': 1.0 + 0.02 * nrm(ks[15], (DEPTH, d), f32),
        'ln1_b': 0.02 * nrm(ks[16], (DEPTH, d), f32),
        'ln2_g': 1.0 + 0.02 * nrm(ks[17], (DEPTH, d), f32),
        'ln2_b': 0.02 * nrm(ks[18], (DEPTH, d), f32),
    }


def reference(x, lb_logits, hg_w_in, hg_norm_g, hg_w_out, sg_w_in, sg_ln_g, sg_ln_b,
              sg_w_s, sg_b_s, sg_w_out, ffn_w_up, ffn_conv_w, ffn_conv_b, ffn_w_down,
              ln1_g, ln1_b, ln2_g, ln2_b):
    lower_bounds = jnp.cumsum(jax.nn.softmax(lb_logits.astype(jnp.float32), axis=0), axis=0)
    h = x
    for layer in range(DEPTH):
        occ = layer // N_MIXERS
        if layer % N_MIXERS == 0:
            mixed = hgrn2_mixer(h, hg_w_in[occ], hg_norm_g[occ], hg_w_out[occ], lower_bounds[layer])
        else:
            mixed = chunked_gmlp(h, sg_w_in[occ], sg_ln_g[occ], sg_ln_b[occ],
                                 sg_w_s[occ], sg_b_s[occ], sg_w_out[occ])
        h = layer_norm(ALPHA * h + mixed, ln1_g[layer], ln1_b[layer])
        ffn = conv_ffn(h, ffn_w_up[layer], ffn_conv_w[layer], ffn_conv_b[layer], ffn_w_down[layer])
        h = layer_norm(ALPHA * h + ffn, ln2_g[layer], ln2_b[layer])
    return h
```

```cpp
#include <hip/hip_runtime.h>
#include <hip/hip_cooperative_groups.h>
#include <cstdio>
#include <cstdint>
namespace cg = cooperative_groups;
namespace pg8 {
#define PG8_LAS __attribute__((address_space(3)))
typedef unsigned short bf16_t;
typedef short bf16x8 __attribute__((ext_vector_type(8)));
typedef float f32x4 __attribute__((ext_vector_type(4)));
typedef unsigned u32x4 __attribute__((ext_vector_type(4)));
constexpr int BM = 256, BK = 64, HALF = 128, HTB = HALF * BK * 2  , STAGE_BYTES = 8 * HTB, NXCD = 8, WGM = 8;

__host__ __device__ __forceinline__ int lds_byte(int r, int c) { const int st = (r >> 4) * 2 + (c >> 5), rr = r & 15, cc = c & 31, ob = rr * 64 + cc * 2; return st * 1024 + (ob ^ (((ob >> 9) & 1) << 5)); }
__host__ __device__ __forceinline__ void stage_rc(int b, int& R, int& C) { const int st = b / 1024, sb = b % 1024, swz = sb ^ (((sb >> 9) & 1) << 5); R = (st >> 1) * 16 + swz / 64; C = (st & 1) * 32 + (swz % 64) / 2; }
__host__ __device__ __forceinline__ int perm32(int rho) { const int n = rho >> 4, i = rho & 15; return 8 * (i >> 2) + 4 * n + (i & 3); }

struct Unit { int pm, pn; };
struct Gemm { const bf16_t* A; const bf16_t* Bt; int M, N, K; };

struct StaticOrder {
    int nM, nN, nwg, G, c;
    __host__ __device__ void init(int M, int N, int G_, int c_) { nM = M / BM; nN = N / BM; nwg = nM * nN; G = G_; c = c_; }
    __host__ __device__ bool next(int i, Unit& u) const {
        const long L = (long)i * G + c; if (L >= nwg) return false;
        int wgid = (int)L; { const int q = nwg / NXCD, r = nwg % NXCD, xcd = wgid % NXCD, off = wgid / NXCD; wgid = (xcd < r ? xcd * (q + 1) : r * (q + 1) + (xcd - r) * q) + off; }
        const int nig = WGM * nN, gid = wgid / nig, fm = gid * WGM, gsz = (nM - fm) < WGM ? (nM - fm) : WGM;
        u.pm = fm + ((wgid % nig) % gsz); u.pn = (wgid % nig) / gsz; return true;
    }
    __device__ __forceinline__ void a_ready(const Unit&) const {}
    __device__ __forceinline__ void done(const Unit&) const {}
};

__device__ __forceinline__ unsigned cvt_pk_bf16(float lo, float hi) { unsigned r; asm volatile("v_cvt_pk_bf16_f32 %0, %1, %2" : "=v"(r) : "v"(lo), "v"(hi)); return r; }
typedef float f32x2 __attribute__((ext_vector_type(2)));
__device__ __forceinline__ f32x2 gelu_pk(f32x2 v) {
    const f32x2 av = __builtin_elementwise_abs(v), d = av * 0.2316418882f + 1.0f;
    f32x2 t; t.x = __builtin_amdgcn_rcpf(d.x); t.y = __builtin_amdgcn_rcpf(d.y);
    f32x2 q = t * 0.5307027145f + (-0.7265760135f); q = q * t + 0.7107068705f; q = q * t + (-0.142248368f); q = q * t + 0.127414796f; q = q * t;
    const f32x2 s = (v * v) * (-0.72134752044f);
    f32x2 e; e.x = __builtin_amdgcn_exp2f(s.x); e.y = __builtin_amdgcn_exp2f(s.y);
    const f32x2 m = v * (q * e), r = v - m;
    f32x2 o; o.x = v.x < 0.f ? m.x : r.x; o.y = v.y < 0.f ? m.y : r.y; return o;
}

template <class Epi, class Sched, bool ALIGN_EPI = false, bool SP2 = false>
__device__ __forceinline__ void gemm_phase(PG8_LAS unsigned char* lds, const Gemm g, const Sched& S, const Epi& E) {
    const int tid = threadIdx.x, wid = __builtin_amdgcn_readfirstlane(tid >> 6), lane = tid & 63, wr = wid >> 2, wc = wid & 3, fr = lane & 15, fq = lane >> 4;
    const int K = g.K, nt = K / BK;
    unsigned voffA[2], voffB[2];
#pragma unroll
    for (int i = 0; i < 2; ++i) { int R, C; stage_rc(tid * 16 + i * 8192, R, C); const int Rb = Epi::PERM ? ((R & ~31) + perm32(R & 31)) : R;
        voffA[i] = (unsigned)(R * K + C) * 2u; voffB[i] = (unsigned)(Rb * K + C) * 2u; }
    const size_t kstep = (size_t)(BK * 2);
    const size_t hstep = (size_t)HALF * K * 2;
    const size_t tstep = 2 * hstep;
    const unsigned ldsw = (unsigned)wid * 1024u;
    const int aoff = lds_byte(wr * 64 + fr, fq * 8), boff = lds_byte(wc * 32 + fr, fq * 8);
#define PG8_SA(b, h) (((b) * 2 + (h)) * HTB)
#define PG8_SB(b, h) ((4 + (b) * 2 + (h)) * HTB)
#define PG8_STAGE(bufoff, gbase, voff) do { _Pragma("unroll") for (int _i = 0; _i < 2; ++_i) \
        __builtin_amdgcn_global_load_lds((const unsigned*)((const char*)(gbase) + (voff)[_i]), (PG8_LAS unsigned*)(lds + (bufoff) + ldsw + _i * 8192), 16, 0, 0); } while (0)
#define PG8_LDA(dst, b, h) do { _Pragma("unroll") for (int m = 0; m < 4; ++m) _Pragma("unroll") for (int k = 0; k < 2; ++k) dst[m][k] = *(const PG8_LAS bf16x8*)(lds + PG8_SA(b, h) + aoff + m * 2048 + k * 1024); } while (0)
#define PG8_LDB(dst, b, h) do { _Pragma("unroll") for (int n = 0; n < 2; ++n) _Pragma("unroll") for (int k = 0; k < 2; ++k) dst[n][k] = *(const PG8_LAS bf16x8*)(lds + PG8_SB(b, h) + boff + n * 2048 + k * 1024); } while (0)
#define PG8_MMA(ai, bj, At, Bt) do { __builtin_amdgcn_s_setprio(1); _Pragma("unroll") for (int m = 0; m < 4; ++m) _Pragma("unroll") for (int n = 0; n < 2; ++n) _Pragma("unroll") for (int k = 0; k < 2; ++k) \
        acc[ai][bj][m][n] = __builtin_amdgcn_mfma_f32_16x16x32_bf16(Bt[n][k], At[m][k], acc[ai][bj][m][n], 0, 0, 0); __builtin_amdgcn_s_setprio(0); } while (0)
#define PG8_WAIT_V(n) asm volatile("s_waitcnt vmcnt(" #n ")" ::: "memory")
#define PG8_WAIT_L(n) asm volatile("s_waitcnt lgkmcnt(" #n ")" ::: "memory")
#define PG8_BAR __builtin_amdgcn_s_barrier()
#define PG8_SCHED __builtin_amdgcn_sched_barrier(0)
    Unit cur, nxt; int ui = 0;
    if (!S.next(0, cur)) return;
    f32x4 acc[2][2][4][2];
#pragma unroll
    for (int a = 0; a < 2; ++a)
#pragma unroll
        for (int b = 0; b < 2; ++b)
#pragma unroll
            for (int m = 0; m < 4; ++m)
#pragma unroll
                for (int n = 0; n < 2; ++n) acc[a][b][m][n] = (f32x4){0.f, 0.f, 0.f, 0.f};
    bf16x8 At[4][2], B0[2][2], B1[2][2];
    const char* cA = (const char*)g.A + (size_t)cur.pm * tstep; const char* cB = (const char*)g.Bt + (size_t)cur.pn * tstep;
    S.a_ready(cur);
    if constexpr (SP2) {
        PG8_STAGE(PG8_SB(0, 0), cB, voffB); PG8_STAGE(PG8_SB(0, 1), cB + hstep, voffB); PG8_STAGE(PG8_SA(0, 0), cA, voffA); PG8_STAGE(PG8_SA(0, 1), cA + hstep, voffA);
        if (wr == 1) PG8_BAR;
        PG8_WAIT_V(2); PG8_BAR;
        PG8_STAGE(PG8_SB(1, 0), cB + kstep, voffB); PG8_STAGE(PG8_SA(1, 0), cA + kstep, voffA); PG8_STAGE(PG8_SB(1, 1), cB + hstep + kstep, voffB);
        PG8_WAIT_V(6); PG8_BAR;
    } else {
        PG8_STAGE(PG8_SB(0, 0), cB, voffB); PG8_STAGE(PG8_SA(0, 0), cA, voffA); PG8_STAGE(PG8_SB(0, 1), cB + hstep, voffB); PG8_STAGE(PG8_SA(0, 1), cA + hstep, voffA);
        if (wr == 1) PG8_BAR;
        PG8_WAIT_V(4); PG8_BAR;
        PG8_STAGE(PG8_SB(1, 0), cB + kstep, voffB); PG8_STAGE(PG8_SA(1, 0), cA + kstep, voffA); PG8_STAGE(PG8_SB(1, 1), cB + hstep + kstep, voffB);
        PG8_WAIT_V(6); PG8_BAR;
    }
    for (;;) {
        const bool has_next = S.next(ui + 1, nxt);
        const char* nA = has_next ? (const char*)g.A + (size_t)nxt.pm * tstep : cA; const char* nB = has_next ? (const char*)g.Bt + (size_t)nxt.pn * tstep : cB;
        for (int t = 0; t < nt; t += 2) {
            const bool last = (t == nt - 2);
            const char* a1 = cA + (size_t)(t + 1) * kstep;
            const char* a2 = last ? nA : cA + (size_t)(t + 2) * kstep; const char* b2 = last ? nB : cB + (size_t)(t + 2) * kstep;
            const char* a3 = a2 + kstep; const char* b3 = b2 + kstep;
            if (last && has_next) S.a_ready(nxt);
            if constexpr (SP2) {
            PG8_LDB(B0, 0, 0); PG8_LDB(B1, 0, 1); PG8_SCHED; PG8_LDA(At, 0, 0); PG8_STAGE(PG8_SA(1, 1), a1 + hstep, voffA);
            PG8_WAIT_V(8); PG8_WAIT_L(0); PG8_BAR; PG8_MMA(0, 0, At, B0); PG8_MMA(0, 1, At, B1); PG8_BAR; PG8_SCHED;
            PG8_LDA(At, 0, 1); PG8_STAGE(PG8_SB(0, 0), b2, voffB); PG8_STAGE(PG8_SB(0, 1), b2 + hstep, voffB); PG8_STAGE(PG8_SA(0, 0), a2, voffA);
            PG8_WAIT_V(8); PG8_WAIT_L(0); PG8_BAR; PG8_MMA(1, 0, At, B0); PG8_MMA(1, 1, At, B1); PG8_BAR; PG8_SCHED;
            PG8_LDB(B0, 1, 0); PG8_LDB(B1, 1, 1); PG8_SCHED; PG8_LDA(At, 1, 0); PG8_STAGE(PG8_SA(0, 1), a2 + hstep, voffA);
            PG8_WAIT_V(8); PG8_WAIT_L(0); PG8_BAR; PG8_MMA(0, 0, At, B0); PG8_MMA(0, 1, At, B1); PG8_BAR; PG8_SCHED;
            PG8_LDA(At, 1, 1); PG8_STAGE(PG8_SB(1, 0), b3, voffB); PG8_STAGE(PG8_SB(1, 1), b3 + hstep, voffB); PG8_STAGE(PG8_SA(1, 0), a3, voffA);
            PG8_WAIT_V(8); PG8_WAIT_L(0); PG8_BAR; PG8_MMA(1, 0, At, B0); PG8_MMA(1, 1, At, B1); PG8_BAR; PG8_SCHED;
            } else {
            PG8_LDB(B0, 0, 0); PG8_SCHED; PG8_LDA(At, 0, 0); PG8_STAGE(PG8_SA(1, 1), a1 + hstep, voffA);
            PG8_WAIT_L(8); PG8_BAR; PG8_WAIT_L(0); PG8_MMA(0, 0, At, B0); PG8_BAR; PG8_SCHED;
            PG8_LDB(B1, 0, 1); PG8_STAGE(PG8_SB(0, 0), b2, voffB);
            PG8_BAR; PG8_WAIT_L(0); PG8_MMA(0, 1, At, B1); PG8_BAR;
            PG8_LDA(At, 0, 1); PG8_STAGE(PG8_SA(0, 0), a2, voffA);
            PG8_BAR; PG8_WAIT_L(0); PG8_MMA(1, 0, At, B0); PG8_BAR; PG8_SCHED;
            PG8_STAGE(PG8_SB(0, 1), b2 + hstep, voffB);
            PG8_WAIT_V(6); PG8_BAR; PG8_MMA(1, 1, At, B1); PG8_BAR;
            PG8_LDB(B0, 1, 0); PG8_SCHED; PG8_LDA(At, 1, 0); PG8_STAGE(PG8_SA(0, 1), a2 + hstep, voffA);
            PG8_WAIT_L(8); PG8_BAR; PG8_WAIT_L(0); PG8_MMA(0, 0, At, B0); PG8_BAR; PG8_SCHED;
            PG8_LDB(B1, 1, 1); PG8_STAGE(PG8_SB(1, 0), b3, voffB);
            PG8_BAR; PG8_WAIT_L(0); PG8_MMA(0, 1, At, B1); PG8_BAR;
            PG8_LDA(At, 1, 1); PG8_STAGE(PG8_SA(1, 0), a3, voffA);
            PG8_BAR; PG8_WAIT_L(0); PG8_MMA(1, 0, At, B0); PG8_BAR; PG8_SCHED;
            PG8_STAGE(PG8_SB(1, 1), b3 + hstep, voffB);
            PG8_WAIT_V(6); PG8_BAR; PG8_MMA(1, 1, At, B1); PG8_BAR;
            }
        }
        if constexpr (ALIGN_EPI) { if (wr == 0) PG8_BAR; }
        if constexpr (!Epi::AFTER_DRAIN) { E(acc, cur, wr, wc, fr, fq); S.done(cur); }
        if (!has_next) break;
#pragma unroll
        for (int a = 0; a < 2; ++a)
#pragma unroll
            for (int b = 0; b < 2; ++b)
#pragma unroll
                for (int m = 0; m < 4; ++m)
#pragma unroll
                    for (int n = 0; n < 2; ++n) acc[a][b][m][n] = (f32x4){0.f, 0.f, 0.f, 0.f};
        cur = nxt; cA = nA; cB = nB; ++ui;
        if constexpr (ALIGN_EPI) { if (wr == 1) PG8_BAR; }
    }
    PG8_WAIT_V(0);
    if constexpr (!ALIGN_EPI) { if (wr == 0) PG8_BAR; }
    PG8_BAR;
    if constexpr (Epi::AFTER_DRAIN) { E.fused(acc, cur, wr, wc, fr, fq, lds, wid, lane); S.done(cur); }
#undef PG8_SA
#undef PG8_SB
#undef PG8_STAGE
#undef PG8_LDA
#undef PG8_LDB
#undef PG8_MMA
#undef PG8_WAIT_V
#undef PG8_WAIT_L
#undef PG8_BAR
#undef PG8_SCHED
}
}

using pg8::bf16_t; using pg8::bf16x8; using pg8::f32x4; using pg8::u32x4; using pg8::f32x2; using pg8::cvt_pk_bf16;
#define LAS __attribute__((address_space(3)))
#define DI __device__ __forceinline__
typedef float f32x16 __attribute__((ext_vector_type(16)));
typedef unsigned u32x2 __attribute__((ext_vector_type(2)));
typedef float f32x2v __attribute__((ext_vector_type(2)));
typedef _Float16 h16x4 __attribute__((ext_vector_type(4)));
typedef _Float16 h16x2 __attribute__((ext_vector_type(2)));

#define XB_TMO      128
#define XB_XCNT(j)  (256  + 64 * (j))
#define XB_XSUB(j)  (1280 + 64 * (j))
#define XB_XGEN(j)  (2304 + 64 * (j))
#define XB_TOP      3328
#define XB_TOPGEN   3392
#define XCD_BAR_WORDS 3456
#define XB_SPIN_CAP (1u << 18)

__device__ __forceinline__ unsigned xb_ld(unsigned* p)              { return __hip_atomic_load(p, __ATOMIC_RELAXED, __HIP_MEMORY_SCOPE_AGENT); }
__device__ __forceinline__ unsigned xb_add(unsigned* p, unsigned v) { return __hip_atomic_fetch_add(p, v, __ATOMIC_RELAXED, __HIP_MEMORY_SCOPE_AGENT); }
__device__ __forceinline__ unsigned xb_xcc_id() { return (unsigned)__builtin_amdgcn_s_getreg((3 << 11) | 20) & 0xFu; }
#define XB_SPIN(cond, bar) do { unsigned _sp = 0; while (cond) { __builtin_amdgcn_s_sleep(1); \
    if ((++_sp & 255u) == 0u) { if (xb_ld(&(bar)[XB_TMO])) break; if (_sp > XB_SPIN_CAP) { atomicAdd(&(bar)[XB_TMO], 1u); break; } } } } while (0)

struct XcdBarrier {
    unsigned* bar; unsigned x;
    volatile LAS unsigned* st;
};

__device__ __forceinline__ XcdBarrier xcd_barrier_post(unsigned* bar, volatile LAS unsigned* st) {
    XcdBarrier b; b.bar = bar; b.x = xb_xcc_id(); b.st = st;
    if (threadIdx.x == 0) (void)xb_add(&bar[XB_XCNT(b.x)], 1u);
    return b;
}
__device__ __forceinline__ void xcd_barrier_complete(unsigned* bar, unsigned x, unsigned& nloc, unsigned& nx) {
    const unsigned G = gridDim.x * gridDim.y * gridDim.z;
    unsigned sum, cnt, mine, sp = 0u;
    for (;;) {
        sum = 0u; cnt = 0u; mine = 0u;
#pragma unroll
        for (unsigned j = 0; j < 16; ++j) { const unsigned c = xb_ld(&bar[XB_XCNT(j)]); sum += c; cnt += (c > 0u) ? 1u : 0u; mine = (j == x) ? c : mine; }
        if (sum == G) break;
        __builtin_amdgcn_s_sleep(1);
        if ((++sp & 255u) == 0u) { if (xb_ld(&bar[XB_TMO])) break; if (sp > XB_SPIN_CAP) { atomicAdd(&bar[XB_TMO], 1u); break; } }
    }
    nloc = mine > 0u ? mine : 1u; nx = cnt > 0u ? cnt : 1u;
}

__device__ __forceinline__ void xcd_barrier(const XcdBarrier& b) {
    asm volatile("s_waitcnt vmcnt(0)" ::: "memory");
    __syncthreads();
    if (threadIdx.x == 0) {
        unsigned* bar = b.bar;
        __builtin_amdgcn_s_waitcnt(0);
        unsigned nloc = b.st[0], nx = b.st[1];
        if (nloc == 0u) { xcd_barrier_complete(bar, b.x, nloc, nx); b.st[0] = nloc; b.st[1] = nx; }
        const unsigned old = xb_add(&bar[XB_XSUB(b.x)], 1u);
        const unsigned gen = old / nloc;
        if (old + 1u == (gen + 1u) * nloc) {
            __builtin_amdgcn_fence(__ATOMIC_RELEASE, "agent");
            asm volatile("s_waitcnt vmcnt(0)" ::: "memory");
            const unsigned og = xb_add(&bar[XB_TOP], 1u);
            const unsigned tg = og / nx;
            if (og + 1u == (tg + 1u) * nx) xb_add(&bar[XB_TOPGEN], 1u);
            else XB_SPIN(xb_ld(&bar[XB_TOPGEN]) == tg, bar);
            __builtin_amdgcn_fence(__ATOMIC_ACQUIRE, "agent");
            xb_add(&bar[XB_XGEN(b.x)], 1u);
            asm volatile("s_waitcnt vmcnt(0)" ::: "memory");
        } else {
            XB_SPIN(xb_ld(&bar[XB_XGEN(b.x)]) == gen, bar);
            __builtin_amdgcn_fence(__ATOMIC_ACQUIRE, "agent");
            asm volatile("s_waitcnt vmcnt(0)" ::: "memory");
        }
    }
    __syncthreads();
}


constexpr int BATCH = 8, SEQ = 4096, D = 2048, M = BATCH * SEQ;
constexpr int HG_N = 8192, NHEAD = 16;
constexpr int SG_N = 4096;
constexpr int DFF = 5632, UP_N = 2 * DFF;
constexpr float ALPHA = 1.41421356237309515f;
constexpr float LN_EPS = 1e-5f, RMS_EPS = 1e-6f;
constexpr int NPHASE = 14;

constexpr size_t MiB = 1u << 20;
constexpr size_t WS_W_HGIN = 0, WS_W_HGOUT = 32 * MiB, WS_W_SGIN = 40 * MiB, WS_W_SGOUT = 56 * MiB;
constexpr size_t WS_W_UP0 = 64 * MiB, WS_W_UP1 = 108 * MiB, WS_W_DN0 = 152 * MiB, WS_W_DN1 = 174 * MiB;
constexpr size_t WS_XB = 196 * MiB;
constexpr size_t WS_Q = 324 * MiB, WS_V = 452 * MiB, WS_GT = 580 * MiB, WS_LF = 708 * MiB;
constexpr size_t WS_H = 768 * MiB;
constexpr size_t WS_GH = 324 * MiB, WS_FA = 676 * MiB, WS_FB = 720 * MiB;
constexpr size_t T_LB = 0;
constexpr size_t T_STAT = 1 * MiB;
constexpr size_t T_WSB = 2 * MiB;
constexpr size_t T_CS = 3 * MiB;
constexpr size_t T_CS_UP0 = T_CS, T_CS_SGIN = T_CS + 2 * 11264 * 4, T_CS_UP1 = T_CS_SGIN + 2 * 4096 * 4;
constexpr size_t T_STATV = 4 * MiB;
constexpr size_t T_ZERO_LO = 1 * MiB, T_ZERO_HI = 5 * MiB;
constexpr size_t T_BAR = 250 * MiB;
constexpr size_t WS_U = 324 * MiB, WS_VV = 452 * MiB;
constexpr size_t WS_ST3 = 1000 * MiB;
constexpr size_t WS_NEED = 1024 * MiB;
constexpr int LDS_BYTES = 139520, LDS_BARST = 139264;

struct Args { const float* in[19]; float* out; unsigned char* ws; int ph_lo, ph_hi; };
#define TMP_(a, off) ((unsigned char*)(a).out + (off))

DI float bf_lo(unsigned u) { return __uint_as_float(u << 16); }
DI float bf_hi(unsigned u) { return __uint_as_float(u & 0xffff0000u); }
DI float silu_f(float x) { return x * __builtin_amdgcn_rcpf(1.0f + __expf(-x)); }
DI float wave_sum(float v) {
#pragma unroll
    for (int o = 1; o < 64; o <<= 1) v += __shfl_xor(v, o);
    return v;
}
#define LDS_WAIT() asm volatile("s_waitcnt lgkmcnt(0)" ::: "memory")

DI void row_stats(const float* st, int row, float& mu, float& rs) {
    const f32x2v sv = *(const f32x2v*)(st + 2 * (size_t)row);
    mu = sv.x * (1.0f / D); const float var = fmaxf(sv.y * (1.0f / D) - mu * mu, 0.f); rs = rsqrtf(var + LN_EPS);
}
template <int RESMODE, bool LAST>
struct EpiRes {
    static constexpr bool PERM = true, AFTER_DRAIN = false;
    const float* res32; float* out; bf16_t* xb; const float* st_prev; float* st_new; const float* g; const float* b;
    DI void operator()(const f32x4 (&acc)[2][2][4][2], const pg8::Unit& u, int wr, int wc, int fr, int fq) const {
        const int row0 = u.pm * 256 + wr * 64 + fr, col0 = u.pn * 256 + wc * 32 + 8 * fq;
        f32x4 gv[2][2], bv[2][2];
        if (RESMODE) {
#pragma unroll
            for (int bj = 0; bj < 2; ++bj)
#pragma unroll
                for (int n = 0; n < 2; ++n) { gv[bj][n] = *(const f32x4*)(g + col0 + bj * 128 + 4 * n); bv[bj][n] = *(const f32x4*)(b + col0 + bj * 128 + 4 * n); }
        }
        constexpr int NB = RESMODE ? 4 : 2;
#pragma unroll
        for (int ab = 0; ab < 8 / NB; ++ab) {
            const int ai = (ab * NB) >> 2, mb = (ab * NB) & 3;
            f32x4 rv[4][2][2]; u32x4 rb[4][2]; f32x2v sv[4];
#pragma unroll
            for (int m = mb; m < mb + NB; ++m) {
                const int row = row0 + ai * 128 + m * 16;
                const size_t off = (size_t)row * D + col0;
                if (RESMODE) {
                    sv[m] = *(const f32x2v*)(st_prev + 2 * (size_t)row);
#pragma unroll
                    for (int bj = 0; bj < 2; ++bj) rb[m][bj] = *(const u32x4*)(xb + off + bj * 128);
                } else {
#pragma unroll
                    for (int bj = 0; bj < 2; ++bj)
#pragma unroll
                        for (int n = 0; n < 2; ++n) rv[m][bj][n] = *(const f32x4*)(res32 + off + bj * 128 + 4 * n);
                }
            }
#pragma unroll
            for (int m = mb; m < mb + NB; ++m) {
                const int row = row0 + ai * 128 + m * 16;
                const size_t off = (size_t)row * D + col0;
                float mu = 0.f, rs = 1.f;
                if (RESMODE) { mu = sv[m].x * (1.0f / D); const float var = fmaxf(sv[m].y * (1.0f / D) - mu * mu, 0.f); rs = rsqrtf(var + LN_EPS); }
                float s = 0.f, s2 = 0.f;
#pragma unroll
                for (int bj = 0; bj < 2; ++bj) {
                    f32x4 y[2];
#pragma unroll
                    for (int n = 0; n < 2; ++n) {
                        f32x4 r;
                        if (RESMODE) {
                            const unsigned w0 = n ? rb[m][bj].z : rb[m][bj].x, w1 = n ? rb[m][bj].w : rb[m][bj].y;
                            r = (f32x4){bf_lo(w0), bf_hi(w0), bf_lo(w1), bf_hi(w1)};
                            r = (r - mu) * rs * gv[bj][n] + bv[bj][n];
                        } else r = rv[m][bj][n];
                        y[n] = r * ALPHA + acc[ai][bj][m][n];
                        if (LAST) *(f32x4*)(out + off + bj * 128 + 4 * n) = y[n];
                        s += (y[n][0] + y[n][1]) + (y[n][2] + y[n][3]);
                        s2 += (y[n][0] * y[n][0] + y[n][1] * y[n][1]) + (y[n][2] * y[n][2] + y[n][3] * y[n][3]);
                    }
                    if (!LAST) {
                        u32x4 w; w.x = cvt_pk_bf16(y[0][0], y[0][1]); w.y = cvt_pk_bf16(y[0][2], y[0][3]); w.z = cvt_pk_bf16(y[1][0], y[1][1]); w.w = cvt_pk_bf16(y[1][2], y[1][3]);
                        *(u32x4*)(xb + off + bj * 128) = w;
                    }
                }
                if (!LAST) {
                    s += __shfl_xor(s, 16); s += __shfl_xor(s, 32); s2 += __shfl_xor(s2, 16); s2 += __shfl_xor(s2, 32);
                    if (fq == 0) {
                        __hip_atomic_fetch_add(st_new + 2 * (size_t)row, s, __ATOMIC_RELAXED, __HIP_MEMORY_SCOPE_AGENT);
                        __hip_atomic_fetch_add(st_new + 2 * (size_t)row + 1, s2, __ATOMIC_RELAXED, __HIP_MEMORY_SCOPE_AGENT);
                    }
                }
            }
            asm volatile("" ::: "memory");
        }
    }
};

struct EpiHgProj {
    static constexpr bool PERM = true, AFTER_DRAIN = false;
    unsigned char* ws; const float* lb;
    DI void operator()(const f32x4 (&acc)[2][2][4][2], const pg8::Unit& u, int wr, int wc, int fr, int fq) const {
        const int sec = u.pn >> 3, colt = (u.pn & 7) * 256;
        const int row0 = u.pm * 256 + wr * 64 + fr, col0 = colt + wc * 32 + 8 * fq;
        if (sec == 1) {
            f32x4 lbv[2][2];
#pragma unroll
            for (int bj = 0; bj < 2; ++bj)
#pragma unroll
                for (int n = 0; n < 2; ++n) lbv[bj][n] = *(const f32x4*)(lb + col0 + bj * 128 + 4 * n);
#pragma unroll
            for (int ai = 0; ai < 2; ++ai)
#pragma unroll
                for (int m = 0; m < 4; ++m) {
                    _Float16* rowp = (_Float16*)(ws + WS_LF) + (size_t)(row0 + ai * 128 + m * 16) * D + col0;
#pragma unroll
                    for (int bj = 0; bj < 2; ++bj)
#pragma unroll
                        for (int n = 0; n < 2; ++n) {
                            h16x4 o;
#pragma unroll
                            for (int j = 0; j < 4; ++j) {
                                const float x = acc[ai][bj][m][n][j], l = lbv[bj][n][j];
                                const float sg = __builtin_amdgcn_rcpf(1.0f + __expf(-x));
                                o[j] = (_Float16)(l + (1.0f - l) * sg);
                            }
                            __builtin_nontemporal_store(o, (h16x4*)(rowp + bj * 128 + 4 * n));
                        }
                }
        } else {
            bf16_t* base = (bf16_t*)(ws + (sec == 0 ? WS_Q : (sec == 2 ? WS_V : WS_GT)));
            const bool act = (sec != 2);
#pragma unroll
            for (int ai = 0; ai < 2; ++ai)
#pragma unroll
                for (int m = 0; m < 4; ++m) {
                    bf16_t* rowp = base + (size_t)(row0 + ai * 128 + m * 16) * D + col0;
#pragma unroll
                    for (int bj = 0; bj < 2; ++bj) {
                        f32x4 v0 = acc[ai][bj][m][0], v1 = acc[ai][bj][m][1];
                        if (act) {
#pragma unroll
                            for (int j = 0; j < 4; ++j) { v0[j] = silu_f(v0[j]); v1[j] = silu_f(v1[j]); }
                        }
                        u32x4 w; w.x = cvt_pk_bf16(v0[0], v0[1]); w.y = cvt_pk_bf16(v0[2], v0[3]); w.z = cvt_pk_bf16(v1[0], v1[1]); w.w = cvt_pk_bf16(v1[2], v1[3]);
                        __builtin_nontemporal_store(w, (u32x4*)(rowp + bj * 128));
                    }
                }
        }
    }
};

struct EpiGelu {
    static constexpr bool PERM = true, AFTER_DRAIN = false;
    bf16_t* U; bf16_t* VV; const float* st; const float* cs; float* stv;
    DI void operator()(const f32x4 (&acc)[2][2][4][2], const pg8::Unit& u, int wr, int wc, int fr, int fq) const {
        bf16_t* base = (u.pn >> 3) ? VV : U;
        const int colt = (u.pn & 7) * 256;
        const int row0 = u.pm * 256 + wr * 64 + fr, col0 = colt + wc * 32 + 8 * fq;
        const int gcol = u.pn * 256 + wc * 32 + 8 * fq;
        f32x4 c1[2][2], c2[2][2];
#pragma unroll
        for (int bj = 0; bj < 2; ++bj)
#pragma unroll
            for (int n = 0; n < 2; ++n) { c1[bj][n] = *(const f32x4*)(cs + gcol + bj * 128 + 4 * n); c2[bj][n] = *(const f32x4*)(cs + SG_N + gcol + bj * 128 + 4 * n); }
        float mus[2][4], rss[2][4];
#pragma unroll
        for (int ai = 0; ai < 2; ++ai)
#pragma unroll
            for (int m = 0; m < 4; ++m) row_stats(st, row0 + ai * 128 + m * 16, mus[ai][m], rss[ai][m]);
#pragma unroll
        for (int ai = 0; ai < 2; ++ai)
#pragma unroll
            for (int m = 0; m < 4; ++m) {
                bf16_t* rowp = base + (size_t)(row0 + ai * 128 + m * 16) * D + col0;
                const float mu = mus[ai][m], rs = rss[ai][m];
                float vs = 0.f, vs2 = 0.f;
#pragma unroll
                for (int bj = 0; bj < 2; ++bj) {
                    const f32x4 v0 = (acc[ai][bj][m][0] - c1[bj][0] * mu) * rs + c2[bj][0], v1 = (acc[ai][bj][m][1] - c1[bj][1] * mu) * rs + c2[bj][1];
                    const f32x2 a = pg8::gelu_pk((f32x2){v0[0], v0[1]}), b = pg8::gelu_pk((f32x2){v0[2], v0[3]}), c = pg8::gelu_pk((f32x2){v1[0], v1[1]}), d = pg8::gelu_pk((f32x2){v1[2], v1[3]});
                    u32x4 w; w.x = cvt_pk_bf16(a.x, a.y); w.y = cvt_pk_bf16(b.x, b.y); w.z = cvt_pk_bf16(c.x, c.y); w.w = cvt_pk_bf16(d.x, d.y);
                    *(u32x4*)(rowp + bj * 128) = w;
                    vs += ((a.x + a.y) + (b.x + b.y)) + ((c.x + c.y) + (d.x + d.y));
                    vs2 += ((a.x * a.x + a.y * a.y) + (b.x * b.x + b.y * b.y)) + ((c.x * c.x + c.y * c.y) + (d.x * d.x + d.y * d.y));
                }
                if (u.pn >> 3) {
                    vs += __shfl_xor(vs, 16); vs += __shfl_xor(vs, 32); vs2 += __shfl_xor(vs2, 16); vs2 += __shfl_xor(vs2, 32);
                    if (fq == 0) {
                        const size_t row = (size_t)(row0 + ai * 128 + m * 16);
                        __hip_atomic_fetch_add(stv + 2 * row, vs, __ATOMIC_RELAXED, __HIP_MEMORY_SCOPE_AGENT);
                        __hip_atomic_fetch_add(stv + 2 * row + 1, vs2, __ATOMIC_RELAXED, __HIP_MEMORY_SCOPE_AGENT);
                    }
                }
            }
    }
};

struct EpiUp {
    static constexpr bool PERM = true, AFTER_DRAIN = false;
    bf16_t* GH; float* FA; float* FB; const float* cw; const float* cb; const float* st; const float* cs;
    DI void operator()(const f32x4 (&acc)[2][2][4][2], const pg8::Unit& u, int wr, int wc, int fr, int fq) const {
        const int lane = threadIdx.x & 63;
        const int src1 = (lane & 48) | ((lane - 1) & 15), src2 = (lane & 48) | ((lane - 2) & 15);
        u32x2 keep[2][4];
        float mus[2][4], rss[2][4];
#pragma unroll
        for (int ai = 0; ai < 2; ++ai)
#pragma unroll
            for (int m = 0; m < 4; ++m) row_stats(st, u.pm * 256 + ai * 128 + wr * 64 + m * 16 + fr, mus[ai][m], rss[ai][m]);
#pragma unroll
        for (int n = 0; n < 2; ++n) {
            const int colg = u.pn * 128 + wc * 32 + 8 * fq + 4 * n;
            const int gcol = u.pn * 256 + wc * 32 + 8 * fq + 4 * n;
            const f32x4 w0 = *(const f32x4*)(cw + colg), w1 = *(const f32x4*)(cw + DFF + colg), w2 = *(const f32x4*)(cw + 2 * DFF + colg), bb = *(const f32x4*)(cb + colg);
            const f32x4 c1a = *(const f32x4*)(cs + gcol), c2a = *(const f32x4*)(cs + UP_N + gcol), c1b = *(const f32x4*)(cs + gcol + 128), c2b = *(const f32x4*)(cs + UP_N + gcol + 128);
#pragma unroll
            for (int ai = 0; ai < 2; ++ai) {
                const int blk = u.pm * 4 + ai * 2 + wr;
                f32x4 q1 = {0.f, 0.f, 0.f, 0.f}, q2 = {0.f, 0.f, 0.f, 0.f};
#pragma unroll
                for (int m = 0; m < 4; ++m) {
                    const int row = u.pm * 256 + ai * 128 + wr * 64 + m * 16 + fr;
                    const float mu = mus[ai][m], rs = rss[ai][m];
                    const f32x4 av = (acc[ai][0][m][n] - c1a * mu) * rs + c2a;
                    const f32x4 bv = (acc[ai][1][m][n] - c1b * mu) * rs + c2b;
                    f32x4 p1, p2;
#pragma unroll
                    for (int j = 0; j < 4; ++j) {
                        const float r1 = __int_as_float(__builtin_amdgcn_update_dpp(0, __float_as_int(av[j]), 0x121, 0xf, 0xf, false));
                        const float r2 = __int_as_float(__builtin_amdgcn_update_dpp(0, __float_as_int(av[j]), 0x122, 0xf, 0xf, false));
                        p1[j] = fr >= 1 ? r1 : q1[j]; p2[j] = fr >= 2 ? r2 : q2[j];
                        q1[j] = r1; q2[j] = r2;
                    }
                    const f32x4 cv = w2 * av + (w1 * p1 + (w0 * p2 + bb));
                    const f32x4 ex = cv * (-1.44269504088896341f);
                    f32x4 den; den[0] = __builtin_amdgcn_exp2f(ex[0]); den[1] = __builtin_amdgcn_exp2f(ex[1]); den[2] = __builtin_amdgcn_exp2f(ex[2]); den[3] = __builtin_amdgcn_exp2f(ex[3]);
                    den = den + 1.0f;
                    f32x4 rc; rc[0] = __builtin_amdgcn_rcpf(den[0]); rc[1] = __builtin_amdgcn_rcpf(den[1]); rc[2] = __builtin_amdgcn_rcpf(den[2]); rc[3] = __builtin_amdgcn_rcpf(den[3]);
                    const f32x4 o = (cv * rc) * bv;
                    u32x2 w; w.x = cvt_pk_bf16(o[0], o[1]); w.y = cvt_pk_bf16(o[2], o[3]);
                    if (n == 0) keep[ai][m] = w;
                    else __builtin_nontemporal_store((u32x4){keep[ai][m].x, keep[ai][m].y, w.x, w.y}, (u32x4*)(GH + (size_t)row * DFF + colg - 4));
                    if (m == 0 && fr < 2) {
                        __builtin_nontemporal_store(av, (f32x4*)(FA + (size_t)(blk * 4 + 2 + fr) * DFF + colg));
                        __builtin_nontemporal_store(bv, (f32x4*)(FB + (size_t)(blk * 2 + fr) * DFF + colg));
                    }
                    if (m == 3 && fr >= 14) __builtin_nontemporal_store(av, (f32x4*)(FA + (size_t)(blk * 4 + (fr - 14)) * DFF + colg));
                }
            }
            asm volatile("" ::: "memory");
        }
    }
};

template <int MODE  , bool FOLD>
DI void transpose_item(const float* W, int K, int N, bf16_t* WT, LAS float* scr, int item, int lane, const float* lg, const float* lbv, float* cs) {
    const int nblk = N / 32, kb = item / nblk, nb = item % nblk, k0 = 64 * kb, n0 = 32 * nb;
    {
        const int krow = lane >> 3, n4 = (lane & 7) * 4;
        f32x4 t[8];
#pragma unroll
        for (int i = 0; i < 8; ++i) t[i] = *(const f32x4*)(W + (size_t)(k0 + 8 * i + krow) * N + n0 + n4);
#pragma unroll
        for (int i = 0; i < 8; ++i) { LAS float* d = scr + (8 * i + krow) * 33 + n4; d[0] = t[i][0]; d[1] = t[i][1]; d[2] = t[i][2]; d[3] = t[i][3]; }
    }
    LDS_WAIT();
    const int c = lane & 7;
    int r0 = n0;
    if (MODE == 1) r0 = (n0 < DFF) ? ((n0 >> 7) * 256 + (n0 & 127)) : (((n0 - DFF) >> 7) * 256 + 128 + ((n0 - DFF) & 127));
    float gk[8], bk[8];
    if (FOLD) {
        const f32x4 g0 = *(const f32x4*)(lg + k0 + 8 * c), g1 = *(const f32x4*)(lg + k0 + 8 * c + 4), b0 = *(const f32x4*)(lbv + k0 + 8 * c), b1 = *(const f32x4*)(lbv + k0 + 8 * c + 4);
#pragma unroll
        for (int i = 0; i < 4; ++i) { gk[i] = g0[i]; gk[4 + i] = g1[i]; bk[i] = b0[i]; bk[4 + i] = b1[i]; }
    }
#pragma unroll
    for (int j = 0; j < 4; ++j) {
        const int n = (lane >> 3) + 8 * j; const LAS float* s = scr + (8 * c) * 33 + n;
        float v[8]; float t1 = 0.f;
#pragma unroll
        for (int i = 0; i < 8; ++i) { v[i] = s[i * 33]; if (FOLD) { t1 += v[i] * bk[i]; v[i] *= gk[i]; } }
        u32x4 o; o.x = cvt_pk_bf16(v[0], v[1]); o.y = cvt_pk_bf16(v[2], v[3]); o.z = cvt_pk_bf16(v[4], v[5]); o.w = cvt_pk_bf16(v[6], v[7]);
        *(u32x4*)(WT + (size_t)(r0 + n) * K + k0 + 8 * c) = o;
        if (FOLD) {
            float t0 = ((bf_lo(o.x) + bf_hi(o.x)) + (bf_lo(o.y) + bf_hi(o.y))) + ((bf_lo(o.z) + bf_hi(o.z)) + (bf_lo(o.w) + bf_hi(o.w)));
            t0 += __shfl_xor(t0, 1); t0 += __shfl_xor(t0, 2); t0 += __shfl_xor(t0, 4);
            t1 += __shfl_xor(t1, 1); t1 += __shfl_xor(t1, 2); t1 += __shfl_xor(t1, 4);
            if (c == 0) {
                __hip_atomic_fetch_add(cs + r0 + n, t0, __ATOMIC_RELAXED, __HIP_MEMORY_SCOPE_AGENT);
                __hip_atomic_fetch_add(cs + N + r0 + n, t1, __ATOMIC_RELAXED, __HIP_MEMORY_SCOPE_AGENT);
            }
        }
    }
    LDS_WAIT();
}

DI void prologue_phase(const Args& a, LAS unsigned char* lds) {
    const int tid = threadIdx.x, lane = tid & 63, wave = tid >> 6;
    const int G = gridDim.x, gw = blockIdx.x * 8 + wave, NGW = G * 8;
    unsigned char* ws = a.ws;
    LAS float* scr = (LAS float*)(lds + wave * 8704);
    constexpr int I_HGIN = 32 * (HG_N / 32);
    for (int it = gw; it < I_HGIN; it += NGW) transpose_item<0, false>(a.in[2], D, HG_N, (bf16_t*)(ws + WS_W_HGIN), scr, it, lane, nullptr, nullptr, nullptr);
    const size_t gt = (size_t)blockIdx.x * 512 + tid, NT = (size_t)G * 512;
    {
        const float* x = a.in[0]; bf16_t* xb = (bf16_t*)(ws + WS_XB);
        for (size_t i = gt; i < (size_t)M * D / 8; i += 4 * NT) {
            f32x4 v0[4], v1[4];
#pragma unroll
            for (int k = 0; k < 4; ++k) { const size_t j = i + (size_t)k * NT; if (j < (size_t)M * D / 8) { v0[k] = *(const f32x4*)(x + j * 8); v1[k] = *(const f32x4*)(x + j * 8 + 4); } }
#pragma unroll
            for (int k = 0; k < 4; ++k) { const size_t j = i + (size_t)k * NT; if (j < (size_t)M * D / 8) {
                u32x4 w; w.x = cvt_pk_bf16(v0[k][0], v0[k][1]); w.y = cvt_pk_bf16(v0[k][2], v0[k][3]); w.z = cvt_pk_bf16(v1[k][0], v1[k][1]); w.w = cvt_pk_bf16(v1[k][2], v1[k][3]);
                *(u32x4*)(xb + j * 8) = w; } }
        }
    }
    {
        u32x4* z0 = (u32x4*)TMP_(a, T_ZERO_LO); u32x4* z1 = (u32x4*)(ws + WS_ST3);
        const u32x4 zero = {0u, 0u, 0u, 0u};
        for (size_t i = gt; i < (T_ZERO_HI - T_ZERO_LO) / 16; i += NT) z0[i] = zero;
        for (size_t i = gt; i < (size_t)M * 8 / 16; i += NT) z1[i] = zero;
    }
    {
        const float* l = a.in[1]; float* lb = (float*)TMP_(a, T_LB);
        for (size_t i = gt; i < (size_t)D; i += NT) {
            const float l0 = l[i], l1 = l[D + i], l2 = l[2 * D + i];
            const float mx = fmaxf(l0, fmaxf(l1, l2));
            const float e0 = expf(l0 - mx), e1 = expf(l1 - mx), e2 = expf(l2 - mx);
            lb[i] = e0 / (e0 + e1 + e2);
        }
    }
}
DI void convert_rest(const Args& a, LAS unsigned char* lds, int gw, int NGW) {
    const int lane = threadIdx.x & 63, wave = threadIdx.x >> 6;
    unsigned char* ws = a.ws;
    LAS float* scr = (LAS float*)(lds + wave * 8704);
    constexpr int I_SQ = 32 * (D / 32), I_SGIN = 32 * (SG_N / 32), I_UP = 32 * (UP_N / 32), I_DN = (DFF / 64) * (D / 32);
    constexpr int NITEMS = 2 * I_SQ + I_SGIN + 2 * I_UP + 2 * I_DN;
    for (int it = gw; it < NITEMS; it += NGW) {
        int r = it;
        if (r < I_SQ) { transpose_item<0, false>(a.in[4], D, D, (bf16_t*)(ws + WS_W_HGOUT), scr, r, lane, nullptr, nullptr, nullptr); continue; } r -= I_SQ;
        if (r < I_UP) { transpose_item<1, true>(a.in[11], D, UP_N, (bf16_t*)(ws + WS_W_UP0), scr, r, lane, a.in[15], a.in[16], (float*)TMP_(a, T_CS_UP0)); continue; } r -= I_UP;
        if (r < I_DN) { transpose_item<0, false>(a.in[14], DFF, D, (bf16_t*)(ws + WS_W_DN0), scr, r, lane, nullptr, nullptr, nullptr); continue; } r -= I_DN;
        if (r < I_SGIN) { transpose_item<0, true>(a.in[5], D, SG_N, (bf16_t*)(ws + WS_W_SGIN), scr, r, lane, a.in[17], a.in[18], (float*)TMP_(a, T_CS_SGIN)); continue; } r -= I_SGIN;
        if (r < I_SQ) { transpose_item<0, false>(a.in[10], D, D, (bf16_t*)(ws + WS_W_SGOUT), scr, r, lane, nullptr, nullptr, nullptr); continue; } r -= I_SQ;
        if (r < I_UP) { transpose_item<1, true>(a.in[11] + (size_t)D * UP_N, D, UP_N, (bf16_t*)(ws + WS_W_UP1), scr, r, lane, a.in[15] + D, a.in[16] + D, (float*)TMP_(a, T_CS_UP1)); continue; } r -= I_UP;
        transpose_item<0, false>(a.in[14] + (size_t)DFF * D, DFF, D, (bf16_t*)(ws + WS_W_DN1), scr, r, lane, nullptr, nullptr, nullptr);
    }
}

DI void wsb_phase(const Args& a, size_t gt, size_t NT) {
    const float* w = a.in[8]; bf16_t* wb = (bf16_t*)TMP_(a, T_WSB);
    for (size_t i = gt; i < (size_t)16 * 128 * 128 / 2; i += NT) {
        const size_t e = i * 2; const int s = (int)(e & 127), t = (int)((e >> 7) & 127);
        const float v0 = (s <= t) ? w[e] : 0.f, v1 = (s + 1 <= t) ? w[e + 1] : 0.f;
        *(unsigned*)(wb + e) = cvt_pk_bf16(v0, v1);
    }
}

DI void ln_phase(const float* Y, float* Hout, bf16_t* XB, const float* g, const float* b) {
    const int tid = threadIdx.x, lane = tid & 63, wave = tid >> 6;
    const int gw = blockIdx.x * 8 + wave, NGW = gridDim.x * 8;
    for (int row = gw; row < M; row += NGW) {
        const f32x4* yr = (const f32x4*)(Y + (size_t)row * D) + lane;
        f32x4 v[8]; float s = 0.f;
#pragma unroll
        for (int j = 0; j < 8; ++j) { v[j] = yr[64 * j]; s += (v[j][0] + v[j][1]) + (v[j][2] + v[j][3]); }
        const float mean = wave_sum(s) * (1.0f / D); float s2 = 0.f;
#pragma unroll
        for (int j = 0; j < 8; ++j) { v[j] = v[j] - mean; s2 += (v[j][0] * v[j][0] + v[j][1] * v[j][1]) + (v[j][2] * v[j][2] + v[j][3] * v[j][3]); }
        const float rstd = rsqrtf(wave_sum(s2) * (1.0f / D) + LN_EPS);
        f32x4* ho = (f32x4*)(Hout + (size_t)row * D) + lane;
        u32x2* xo = XB ? (u32x2*)(XB + (size_t)row * D) + lane : nullptr;
#pragma unroll
        for (int j = 0; j < 8; ++j) {
            const f32x4 gg = ((const f32x4*)g)[lane + 64 * j], bb = ((const f32x4*)b)[lane + 64 * j];
            const f32x4 o = v[j] * rstd * gg + bb;
            ho[64 * j] = o;
            if (XB) { u32x2 w; w.x = cvt_pk_bf16(o[0], o[1]); w.y = cvt_pk_bf16(o[2], o[3]); xo[64 * j] = w; }
        }
    }
}

DI void final_ln_phase(const bf16_t* Y, const float* st, float* out, const float* g, const float* b) {
    const size_t gt = (size_t)blockIdx.x * 512 + threadIdx.x, NT = (size_t)gridDim.x * 512;
    for (size_t i = gt; i < (size_t)M * (D / 8); i += NT) {
        const size_t row = i >> 8; const int c8 = (int)(i & 255) * 8;
        const u32x4 y = *(const u32x4*)(Y + row * D + c8);
        float mu, rs; row_stats(st, (int)row, mu, rs);
        const f32x4 g0 = *(const f32x4*)(g + c8), g1 = *(const f32x4*)(g + c8 + 4), b0 = *(const f32x4*)(b + c8), b1 = *(const f32x4*)(b + c8 + 4);
        const f32x4 v0 = {bf_lo(y.x), bf_hi(y.x), bf_lo(y.y), bf_hi(y.y)}, v1 = {bf_lo(y.z), bf_hi(y.z), bf_lo(y.w), bf_hi(y.w)};
        *(f32x4*)(out + row * D + c8) = (v0 - mu) * rs * g0 + b0;
        *(f32x4*)(out + row * D + c8 + 4) = (v1 - mu) * rs * g1 + b1;
    }
}

DI void fixup_phase(bf16_t* GH, const float* FA, const float* FB, const float* cw, const float* cb) {
    constexpr int C4 = DFF / 4;
    for (int r0 = blockIdx.x * 4; r0 < 1024; r0 += gridDim.x * 4) {
        for (int c4 = threadIdx.x; c4 < C4; c4 += 512) {
            const int col = 4 * c4;
            const f32x4 w0 = *(const f32x4*)(cw + col), w1 = *(const f32x4*)(cw + DFF + col), w2 = *(const f32x4*)(cw + 2 * DFF + col), bb = *(const f32x4*)(cb + col);
            f32x4 am2[4], am1[4], a0[4], bv[4];
#pragma unroll
            for (int q = 0; q < 4; ++q) {
                const int ri = r0 + q, blk = ri >> 1, rr = ri & 1;
                const bool first = (blk & 63) == 0;
                const f32x4 z = {0.f, 0.f, 0.f, 0.f};
                if (rr == 0) {
                    am2[q] = first ? z : *(const f32x4*)(FA + (size_t)((blk - 1) * 4 + 0) * DFF + col);
                    am1[q] = first ? z : *(const f32x4*)(FA + (size_t)((blk - 1) * 4 + 1) * DFF + col);
                    a0[q] = *(const f32x4*)(FA + (size_t)(blk * 4 + 2) * DFF + col);
                    bv[q] = *(const f32x4*)(FB + (size_t)(blk * 2 + 0) * DFF + col);
                } else {
                    am2[q] = first ? z : *(const f32x4*)(FA + (size_t)((blk - 1) * 4 + 1) * DFF + col);
                    am1[q] = *(const f32x4*)(FA + (size_t)(blk * 4 + 2) * DFF + col);
                    a0[q] = *(const f32x4*)(FA + (size_t)(blk * 4 + 3) * DFF + col);
                    bv[q] = *(const f32x4*)(FB + (size_t)(blk * 2 + 1) * DFF + col);
                }
            }
#pragma unroll
            for (int q = 0; q < 4; ++q) {
                const int ri = r0 + q, blk = ri >> 1, rr = ri & 1;
                float o[4];
#pragma unroll
                for (int j = 0; j < 4; ++j) { const float cv = w2[j] * a0[q][j] + w1[j] * am1[q][j] + w0[j] * am2[q][j] + bb[j]; o[j] = silu_f(cv) * bv[q][j]; }
                u32x2 w; w.x = cvt_pk_bf16(o[0], o[1]); w.y = cvt_pk_bf16(o[2], o[3]);
                *(u32x2*)(GH + (size_t)(blk * 64 + rr) * DFF + col) = w;
            }
        }
    }
}

template <int NS>
DI void mma32u(f32x16& acc, const LAS unsigned char* A, int sa, const LAS unsigned char* Bt, int sb, int r, int h) {
    const LAS unsigned char* pa = A + r * sa + h * 16; const LAS unsigned char* pb = Bt + r * sb + h * 16;
    bf16x8 av[NS], bv[NS];
#pragma unroll
    for (int s = 0; s < NS; ++s) { av[s] = *(const LAS bf16x8*)(pa + s * 32); bv[s] = *(const LAS bf16x8*)(pb + s * 32); }
#pragma unroll
    for (int s = 0; s < NS; ++s) acc = __builtin_amdgcn_mfma_f32_32x32x16_bf16(av[s], bv[s], acc, 0, 0, 0);
}
DI int crow(int reg, int h) { return (reg & 3) + 8 * (reg >> 2) + 4 * h; }

namespace scan {
constexpr int QT = 0, KT = 17408, OF = 0, KTT = 34816, VT = 53248, PM = 71680, ST = 80896, CP = 115712, EL = 119808;
constexpr int S272 = 272, S144 = 144, SOF = 528;
}
DI void scan_phase(LAS unsigned char* lds, const bf16_t* Qb, const _Float16* LF, const bf16_t* Vb, const bf16_t* Gb, bf16_t* Ob, const float* norm_g, int item0, int istride) {
    using namespace scan;
    const int tid = threadIdx.x, lane = tid & 63, w = __builtin_amdgcn_readfirstlane(tid >> 6);
    const int r = lane & 31, h = lane >> 5;
    const int kp = lane, oct = w;
    const int e_row = tid >> 3, e_seg = tid & 7;
    for (int item = item0; item < BATCH * NHEAD; item += istride) {
        const int b = item >> 4, hd = item & 15, hc = hd * 128;
        const size_t rowbase = (size_t)b * SEQ;
        f32x16 sacc[2];
#pragma unroll
        for (int i = 0; i < 16; ++i) { sacc[0][i] = 0.f; sacc[1][i] = 0.f; }
        f32x2v lfv[8]; unsigned qv[8], vv[8]; u32x4 gtr[2];
        f32x4 ngr[4];
#pragma unroll
        for (int i = 0; i < 4; ++i) ngr[i] = *(const f32x4*)(norm_g + hc + 16 * e_seg + 4 * i);
        {
            const size_t e0 = (rowbase + 8 * oct) * D + hc + 2 * kp;
#pragma unroll
            for (int i = 0; i < 8; ++i) { { const h16x2 hv = *(const h16x2*)(LF + e0 + (size_t)i * D); lfv[i] = (f32x2v){(float)hv.x, (float)hv.y}; } qv[i] = *(const unsigned*)(Qb + e0 + (size_t)i * D); vv[i] = *(const unsigned*)(Vb + e0 + (size_t)i * D); }
        }
        for (int n = 0; n < SEQ / 64; ++n) {
            float cum0[8], cum1[8]; float c0 = 1.f, c1 = 1.f;
#pragma unroll
            for (int i = 0; i < 8; ++i) { c0 *= lfv[i].x; cum0[i] = c0; c1 *= lfv[i].y; cum1[i] = c1; }
            *(LAS f32x2v*)(lds + CP + (oct * 128 + 2 * kp) * 4) = (f32x2v){c0, c1};
            __syncthreads();
            float off0 = 1.f, off1 = 1.f;
            {
                f32x2v pp[7];
#pragma unroll
                for (int o = 0; o < 7; ++o) pp[o] = *(const LAS f32x2v*)(lds + CP + (o * 128 + 2 * kp) * 4);
#pragma unroll
                for (int o = 0; o < 7; ++o) { off0 *= (o < oct) ? pp[o].x : 1.f; off1 *= (o < oct) ? pp[o].y : 1.f; }
            }
            unsigned kt0[4], kt1[4], vt0[4], vt1[4];
#pragma unroll
            for (int i = 0; i < 8; i += 2) {
                float q0[2], q1[2], k0[2], k1[2];
#pragma unroll
                for (int d = 0; d < 2; ++d) {
                    const float E0 = cum0[i + d] * off0, E1 = cum1[i + d] * off1;
                    const float I0 = fminf(__builtin_amdgcn_rcpf(E0), 5.5e34f), I1 = fminf(__builtin_amdgcn_rcpf(E1), 5.5e34f);
                    const float kk0 = 1.0f - lfv[i + d].x, kk1 = 1.0f - lfv[i + d].y;
                    q0[d] = bf_lo(qv[i + d]) * E0; q1[d] = bf_hi(qv[i + d]) * E1; k0[d] = kk0 * I0; k1[d] = kk1 * I1;
                    const int t = 8 * oct + i + d;
                    *(LAS unsigned*)(lds + QT + t * S272 + 4 * kp) = cvt_pk_bf16(q0[d], q1[d]);
                    *(LAS unsigned*)(lds + KT + t * S272 + 4 * kp) = cvt_pk_bf16(k0[d], k1[d]);
                }
                kt0[i >> 1] = cvt_pk_bf16(k0[0], k0[1]); kt1[i >> 1] = cvt_pk_bf16(k1[0], k1[1]);
                vt0[i >> 1] = (vv[i] & 0xffffu) | (vv[i + 1] << 16); vt1[i >> 1] = (vv[i] >> 16) | (vv[i + 1] & 0xffff0000u);
            }
            *(LAS u32x4*)(lds + KTT + (2 * kp) * S144 + 16 * oct) = (u32x4){kt0[0], kt0[1], kt0[2], kt0[3]};
            *(LAS u32x4*)(lds + KTT + (2 * kp + 1) * S144 + 16 * oct) = (u32x4){kt1[0], kt1[1], kt1[2], kt1[3]};
            *(LAS u32x4*)(lds + VT + (2 * kp) * S144 + 16 * oct) = (u32x4){vt0[0], vt0[1], vt0[2], vt0[3]};
            *(LAS u32x4*)(lds + VT + (2 * kp + 1) * S144 + 16 * oct) = (u32x4){vt1[0], vt1[1], vt1[2], vt1[3]};
            if (oct == 7) *(LAS f32x2v*)(lds + EL + 8 * kp) = (f32x2v){cum0[7] * off0, cum1[7] * off1};
            __syncthreads();
            {
                const size_t ge = (rowbase + (size_t)n * 64 + e_row) * D + hc + 16 * e_seg;
                gtr[0] = *(const u32x4*)(Gb + ge); gtr[1] = *(const u32x4*)(Gb + ge + 8);
            }
            if (n + 1 < SEQ / 64) {
                const size_t e0 = (rowbase + (size_t)(n + 1) * 64 + 8 * oct) * D + hc + 2 * kp;
#pragma unroll
                for (int i = 0; i < 8; ++i) { { const h16x2 hv = *(const h16x2*)(LF + e0 + (size_t)i * D); lfv[i] = (f32x2v){(float)hv.x, (float)hv.y}; } qv[i] = *(const unsigned*)(Qb + e0 + (size_t)i * D); vv[i] = *(const unsigned*)(Vb + e0 + (size_t)i * D); }
            }
            const int tm = w >> 2, tn = w & 3;
            f32x16 oacc;
#pragma unroll
            for (int i = 0; i < 16; ++i) oacc[i] = 0.f;
            if (n > 0) mma32u<8>(oacc, lds + QT + 32 * tm * S272, S272, lds + ST + 32 * tn * S272, S272, r, h);
            if (w < 3) {
                const int pm = (w + 1) >> 1, pn = (w == 2) ? 1 : 0;
                f32x16 pacc;
#pragma unroll
                for (int i = 0; i < 16; ++i) pacc[i] = 0.f;
                mma32u<8>(pacc, lds + QT + 32 * pm * S272, S272, lds + KT + 32 * pn * S272, S272, r, h);
                const int scol = 32 * pn + r;
#pragma unroll
                for (int i = 0; i < 16; i += 1) {
                    const int trow = 32 * pm + crow(i, h);
                    const float val = (scol <= trow) ? pacc[i] : 0.f;
                    *(LAS unsigned short*)(lds + PM + trow * S144 + scol * 2) = (unsigned short)(cvt_pk_bf16(val, 0.f) & 0xffffu);
                }
            }
            __syncthreads();
            if (tm) mma32u<4>(oacc, lds + PM + 32 * tm * S144, S144, lds + VT + 32 * tn * S144, S144, r, h);
            else mma32u<2>(oacc, lds + PM + 32 * tm * S144, S144, lds + VT + 32 * tn * S144, S144, r, h);
#pragma unroll
            for (int i = 0; i < 16; ++i) *(LAS float*)(lds + OF + (32 * tm + crow(i, h)) * SOF + (32 * tn + r) * 4) = oacc[i];
#pragma unroll
            for (int i = 0; i < 2; ++i) {
                const int idx = 2 * w + i, km = idx >> 2, vn = idx & 3;
                mma32u<4>(sacc[i], lds + KTT + 32 * km * S144, S144, lds + VT + 32 * vn * S144, S144, r, h);
#pragma unroll
                for (int g = 0; g < 4; ++g) {
                    const f32x4 el = *(const LAS f32x4*)(lds + EL + (32 * km + 8 * g + 4 * h) * 4);
#pragma unroll
                    for (int j = 0; j < 4; ++j) sacc[i][4 * g + j] *= el[j];
                    u32x2 pk; pk.x = cvt_pk_bf16(sacc[i][4 * g], sacc[i][4 * g + 1]); pk.y = cvt_pk_bf16(sacc[i][4 * g + 2], sacc[i][4 * g + 3]);
                    *(LAS u32x2*)(lds + ST + (32 * vn + r) * S272 + (32 * km + 8 * g + 4 * h) * 2) = pk;
                }
            }
            __syncthreads();
            {
                const int trow = e_row, seg = e_seg;
                const size_t ge = (rowbase + (size_t)n * 64 + trow) * D + hc + 16 * seg;
                f32x4 o[4]; float ss = 0.f;
#pragma unroll
                for (int i = 0; i < 4; ++i) { o[i] = *(const LAS f32x4*)(lds + OF + trow * SOF + (16 * seg + 4 * i) * 4); ss += (o[i][0] * o[i][0] + o[i][1] * o[i][1]) + (o[i][2] * o[i][2] + o[i][3] * o[i][3]); }
                ss += __shfl_xor(ss, 1); ss += __shfl_xor(ss, 2); ss += __shfl_xor(ss, 4);
                const float rms = rsqrtf(ss * (1.0f / 128.0f) + RMS_EPS);
                const unsigned gw[8] = {gtr[0].x, gtr[0].y, gtr[0].z, gtr[0].w, gtr[1].x, gtr[1].y, gtr[1].z, gtr[1].w};
                unsigned ow[8];
#pragma unroll
                for (int i = 0; i < 4; ++i) {
                    const f32x4 ng = ngr[i];
                    const float y0 = o[i][0] * rms * ng[0] * bf_lo(gw[2 * i]), y1 = o[i][1] * rms * ng[1] * bf_hi(gw[2 * i]);
                    const float y2 = o[i][2] * rms * ng[2] * bf_lo(gw[2 * i + 1]), y3 = o[i][3] * rms * ng[3] * bf_hi(gw[2 * i + 1]);
                    ow[2 * i] = cvt_pk_bf16(y0, y1); ow[2 * i + 1] = cvt_pk_bf16(y2, y3);
                }
                *(u32x4*)(Ob + ge) = (u32x4){ow[0], ow[1], ow[2], ow[3]};
                *(u32x4*)(Ob + ge + 8) = (u32x4){ow[4], ow[5], ow[6], ow[7]};
            }
        }
        __syncthreads();
    }
}

namespace sgu { constexpr int WM = 0, VLT = 34816, GT = 69632, STAT = 137216, S272 = 272, SGT = 528; }
DI void spatial_phase(LAS unsigned char* lds, const bf16_t* U, bf16_t* Yout, const bf16_t* VV, const bf16_t* WSB, const float* bs, const float* lng, const float* lnb, const float* stv) {
    using namespace sgu;
    const int tid = threadIdx.x, lane = tid & 63, w = __builtin_amdgcn_readfirstlane(tid >> 6);
    const int r = lane & 31, h = lane >> 5;
    const int cp = lane, to = w;
    const int er = tid >> 4, ec = tid & 15;
    for (int item = blockIdx.x; item < M / 128; item += gridDim.x) {
        const size_t T0 = (size_t)item * 128;
        if (tid < 128) {
            const f32x2v sv = *(const f32x2v*)(stv + 2 * (T0 + tid));
            const float mean = sv.x * (1.0f / D); const float var = fmaxf(sv.y * (1.0f / D) - mean * mean, 0.f);
            *(LAS f32x2v*)(lds + STAT + tid * 8) = (f32x2v){mean, rsqrtf(var + LN_EPS)};
        }
        u32x4 wreg[4]; unsigned vreg[16]; u32x4 ureg[4];
        f32x2v lgr = *(const f32x2v*)(lng + 2 * cp), lbr = *(const f32x2v*)(lnb + 2 * cp);
        float btr[4];
#pragma unroll
        for (int i = 0; i < 4; ++i) btr[i] = bs[er + 32 * i];
#pragma unroll
        for (int i = 0; i < 4; ++i) { const int c = i * 512 + tid; wreg[i] = *(const u32x4*)(WSB + ((size_t)(c >> 4) * 128 + (c & 15) * 8)); }
#pragma unroll
        for (int i = 0; i < 16; ++i) vreg[i] = *(const unsigned*)(VV + (T0 + 16 * to + i) * D + 2 * cp);
#pragma unroll
        for (int i = 0; i < 4; ++i) ureg[i] = *(const u32x4*)(U + (T0 + er + 32 * i) * D + 8 * ec);
        __syncthreads();
        for (int g = 0; g < 16; ++g) {
#pragma unroll
            for (int i = 0; i < 4; ++i) { const int c = i * 512 + tid; *(LAS u32x4*)(lds + WM + (c >> 4) * S272 + (c & 15) * 16) = wreg[i]; }
            {
                const float g0 = lgr.x, g1 = lgr.y, b0 = lbr.x, b1 = lbr.y;
                unsigned a0[8], a1[8];
#pragma unroll
                for (int i = 0; i < 16; i += 2) {
                    float y0[2], y1[2];
#pragma unroll
                    for (int d = 0; d < 2; ++d) {
                        const f32x2v st = *(const LAS f32x2v*)(lds + STAT + (16 * to + i + d) * 8);
                        y0[d] = (bf_lo(vreg[i + d]) - st.x) * st.y * g0 + b0; y1[d] = (bf_hi(vreg[i + d]) - st.x) * st.y * g1 + b1;
                    }
                    a0[i >> 1] = cvt_pk_bf16(y0[0], y0[1]); a1[i >> 1] = cvt_pk_bf16(y1[0], y1[1]);
                }
                *(LAS u32x4*)(lds + VLT + (2 * cp) * S272 + 32 * to) = (u32x4){a0[0], a0[1], a0[2], a0[3]};
                *(LAS u32x4*)(lds + VLT + (2 * cp) * S272 + 32 * to + 16) = (u32x4){a0[4], a0[5], a0[6], a0[7]};
                *(LAS u32x4*)(lds + VLT + (2 * cp + 1) * S272 + 32 * to) = (u32x4){a1[0], a1[1], a1[2], a1[3]};
                *(LAS u32x4*)(lds + VLT + (2 * cp + 1) * S272 + 32 * to + 16) = (u32x4){a1[4], a1[5], a1[6], a1[7]};
            }
            __syncthreads();
            if (g + 1 < 16) {
#pragma unroll
                for (int i = 0; i < 4; ++i) { const int c = i * 512 + tid; wreg[i] = *(const u32x4*)(WSB + ((size_t)((g + 1) * 128 + (c >> 4)) * 128 + (c & 15) * 8)); }
#pragma unroll
                for (int i = 0; i < 16; ++i) vreg[i] = *(const unsigned*)(VV + (T0 + 16 * to + i) * D + (g + 1) * 128 + 2 * cp);
                lgr = *(const f32x2v*)(lng + (g + 1) * 128 + 2 * cp); lbr = *(const f32x2v*)(lnb + (g + 1) * 128 + 2 * cp);
            }
#pragma unroll
            for (int i = 0; i < 2; ++i) {
                const int tm = i ? 3 - (w >> 2) : (w >> 2), tn = w & 3;
                f32x16 acc;
#pragma unroll
                for (int q = 0; q < 16; ++q) acc[q] = 0.f;
                const LAS unsigned char* pa = lds + WM + 32 * tm * S272; const LAS unsigned char* pb = lds + VLT + 32 * tn * S272;
                if (tm == 0) mma32u<2>(acc, pa, S272, pb, S272, r, h);
                else if (tm == 1) mma32u<4>(acc, pa, S272, pb, S272, r, h);
                else if (tm == 2) mma32u<6>(acc, pa, S272, pb, S272, r, h);
                else mma32u<8>(acc, pa, S272, pb, S272, r, h);
#pragma unroll
                for (int q = 0; q < 16; ++q) *(LAS float*)(lds + GT + (32 * tm + crow(q, h)) * SGT + (32 * tn + r) * 4) = acc[q];
            }
            __syncthreads();
#pragma unroll
            for (int i = 0; i < 4; ++i) {
                const int t = er + 32 * i;
                const f32x4 g0 = *(const LAS f32x4*)(lds + GT + t * SGT + ec * 32), g1 = *(const LAS f32x4*)(lds + GT + t * SGT + ec * 32 + 16);
                const float bt = btr[i];
                const u32x4 uu = ureg[i];
                u32x4 o;
                o.x = cvt_pk_bf16(bf_lo(uu.x) * (g0[0] + bt), bf_hi(uu.x) * (g0[1] + bt)); o.y = cvt_pk_bf16(bf_lo(uu.y) * (g0[2] + bt), bf_hi(uu.y) * (g0[3] + bt));
                o.z = cvt_pk_bf16(bf_lo(uu.z) * (g1[0] + bt), bf_hi(uu.z) * (g1[1] + bt)); o.w = cvt_pk_bf16(bf_lo(uu.w) * (g1[2] + bt), bf_hi(uu.w) * (g1[3] + bt));
                *(u32x4*)(Yout + (T0 + t) * D + g * 128 + 8 * ec) = o;
            }
            if (g + 1 < 16) {
#pragma unroll
                for (int i = 0; i < 4; ++i) { ureg[i] = *(const u32x4*)(U + (T0 + er + 32 * i) * D + (g + 1) * 128 + 8 * ec); btr[i] = bs[(g + 1) * 128 + er + 32 * i]; }
            }
        }
        __syncthreads();
    }
}

__global__ void __launch_bounds__(512, 2) mk_fwd(Args a) {
    extern __shared__ __attribute__((aligned(16))) unsigned char lds_raw[];
    LAS unsigned char* lds = (LAS unsigned char*)lds_raw;
    unsigned char* const ws = a.ws;
    const int G = gridDim.x, c = blockIdx.x;
    const int lo = a.ph_lo, hi = a.ph_hi;
    if (threadIdx.x < 2) ((volatile LAS unsigned*)(lds + LDS_BARST))[threadIdx.x] = 0u;
    __syncthreads();
    const XcdBarrier xbar = xcd_barrier_post((unsigned*)TMP_(a, T_BAR), (volatile LAS unsigned*)(lds + LDS_BARST));
    if (lo < 0) cg::this_grid().sync();
#define IN(k) (lo <= (k) && (k) < hi)
#define SEAM(k) do { if (lo <= (k) && (k) + 1 < hi) xcd_barrier(xbar); } while (0)
#define XB_ ((bf16_t*)(ws + WS_XB))
#define H_ ((float*)(ws + WS_H))
#define ST_(i) ((float*)TMP_(a, T_STAT + (size_t)(i) * M * 8))
#define ST3_ ((float*)(ws + WS_ST3))
    if (IN(0)) prologue_phase(a, lds);
    SEAM(0);
    if (IN(1)) {
        pg8::Gemm g{XB_, (const bf16_t*)(ws + WS_W_HGIN), M, HG_N, D}; pg8::StaticOrder S; S.init(M, HG_N, G, c);
        EpiHgProj E{ws, (const float*)TMP_(a, T_LB)};
        pg8::gemm_phase<EpiHgProj, pg8::StaticOrder, true, true>(lds, g, S, E);
    }
    SEAM(1);
    if (IN(2)) {
        const int NS = BATCH * NHEAD;
        if (G >= 2 * NS) {
            if (c < NS) scan_phase(lds, (const bf16_t*)(ws + WS_Q), (const _Float16*)(ws + WS_LF), (const bf16_t*)(ws + WS_V), (const bf16_t*)(ws + WS_GT), (bf16_t*)(ws + WS_Q), a.in[3], c, NS);
            else { convert_rest(a, lds, (c - NS) * 8 + (int)(threadIdx.x >> 6), (G - NS) * 8); wsb_phase(a, (size_t)(c - NS) * 512 + threadIdx.x, (size_t)(G - NS) * 512); }
        } else {
            scan_phase(lds, (const bf16_t*)(ws + WS_Q), (const _Float16*)(ws + WS_LF), (const bf16_t*)(ws + WS_V), (const bf16_t*)(ws + WS_GT), (bf16_t*)(ws + WS_Q), a.in[3], c, G);
            __syncthreads();
            convert_rest(a, lds, c * 8 + (int)(threadIdx.x >> 6), G * 8); wsb_phase(a, (size_t)c * 512 + threadIdx.x, (size_t)G * 512);
        }
    }
    SEAM(2);
    if (IN(3)) {
        pg8::Gemm g{(const bf16_t*)(ws + WS_Q), (const bf16_t*)(ws + WS_W_HGOUT), M, D, D}; pg8::StaticOrder S; S.init(M, D, G, c);
        EpiRes<0, false> E{a.in[0], H_, XB_, nullptr, ST_(0), nullptr, nullptr};
        pg8::gemm_phase<EpiRes<0, false>, pg8::StaticOrder, true, true>(lds, g, S, E);
    }
    SEAM(3);
#define FFN_PHASES(P, layer, si, so, LASTF) \
    if (IN(P)) { \
        pg8::Gemm g{XB_, (const bf16_t*)(ws + ((layer) ? WS_W_UP1 : WS_W_UP0)), M, UP_N, D}; pg8::StaticOrder S; S.init(M, UP_N, G, c); \
        EpiUp E{(bf16_t*)(ws + WS_GH), (float*)(ws + WS_FA), (float*)(ws + WS_FB), a.in[12] + (size_t)(layer) * 3 * DFF, a.in[13] + (size_t)(layer) * DFF, ST_(si), (const float*)TMP_(a, (layer) ? T_CS_UP1 : T_CS_UP0)}; \
        pg8::gemm_phase<EpiUp, pg8::StaticOrder, true, true>(lds, g, S, E); \
    } \
    SEAM(P); \
    if (IN(P + 1)) fixup_phase((bf16_t*)(ws + WS_GH), (const float*)(ws + WS_FA), (const float*)(ws + WS_FB), a.in[12] + (size_t)(layer) * 3 * DFF, a.in[13] + (size_t)(layer) * DFF); \
    SEAM(P + 1); \
    if (IN(P + 2)) { \
        pg8::Gemm g{(const bf16_t*)(ws + WS_GH), (const bf16_t*)(ws + ((layer) ? WS_W_DN1 : WS_W_DN0)), M, D, DFF}; pg8::StaticOrder S; S.init(M, D, G, c); \
        EpiRes<1, LASTF> E{H_, H_, XB_, ST_(si), ((so) == 3 ? ST3_ : ST_(so)), a.in[15] + (layer) * D, a.in[16] + (layer) * D}; \
        pg8::gemm_phase<EpiRes<1, LASTF>, pg8::StaticOrder, true, true>(lds, g, S, E); \
    } \
    SEAM(P + 2);
    FFN_PHASES(4, 0, 0, 1, false)
    if (IN(7)) {
        pg8::Gemm g{XB_, (const bf16_t*)(ws + WS_W_SGIN), M, SG_N, D}; pg8::StaticOrder S; S.init(M, SG_N, G, c);
        EpiGelu E{(bf16_t*)(ws + WS_U), (bf16_t*)(ws + WS_VV), ST_(1), (const float*)TMP_(a, T_CS_SGIN), (float*)TMP_(a, T_STATV)};
        pg8::gemm_phase<EpiGelu, pg8::StaticOrder, true, true>(lds, g, S, E);
    }
    SEAM(7);
    if (IN(8)) spatial_phase(lds, (const bf16_t*)(ws + WS_U), (bf16_t*)(ws + WS_U), (const bf16_t*)(ws + WS_VV), (const bf16_t*)TMP_(a, T_WSB), a.in[9], a.in[6], a.in[7], (const float*)TMP_(a, T_STATV));
    SEAM(8);
    if (IN(9)) {
        pg8::Gemm g{(const bf16_t*)(ws + WS_U), (const bf16_t*)(ws + WS_W_SGOUT), M, D, D}; pg8::StaticOrder S; S.init(M, D, G, c);
        EpiRes<1, false> E{H_, H_, XB_, ST_(1), ST_(2), a.in[17], a.in[18]};
        pg8::gemm_phase<EpiRes<1, false>, pg8::StaticOrder, true, true>(lds, g, S, E);
    }
    SEAM(9);
    FFN_PHASES(10, 1, 2, 3, false)
    if (IN(13)) final_ln_phase(XB_, ST3_, a.out, a.in[17] + D, a.in[18] + D);
#undef IN
#undef SEAM
}

extern "C" void kernel_launch(void* const* d_in, const int* in_sizes, int n_in, void* d_out, int out_size, void* d_ws, size_t ws_size, hipStream_t stream) {
    static int grid = 0;
    if (grid == 0) {
        if (n_in != 19 || in_sizes[0] != M * D || out_size != M * D || ws_size < WS_NEED) {
            fprintf(stderr, "kernel_launch: unexpected problem: n_in %d in0 %d out %d ws %zu (need %zu)\n", n_in, n_in > 0 ? in_sizes[0] : -1, out_size, ws_size, (size_t)WS_NEED);
            grid = -1; return;
        }
        int dev = 0, cus = 0, per_cu = 0;
        hipGetDevice(&dev); hipDeviceGetAttribute(&cus, hipDeviceAttributeMultiprocessorCount, dev);
        hipFuncSetAttribute((const void*)mk_fwd, hipFuncAttributeMaxDynamicSharedMemorySize, LDS_BYTES);
        hipOccupancyMaxActiveBlocksPerMultiprocessor(&per_cu, (const void*)mk_fwd, 512, LDS_BYTES);
        if (per_cu < 1) per_cu = 1;
        grid = cus * per_cu;
        (void)hipGetLastError();
    }
    if (grid < 0) return;
    Args a{};
    for (int i = 0; i < 19; ++i) a.in[i] = (const float*)d_in[i];
    a.out = (float*)d_out; a.ws = (unsigned char*)d_ws;
    (void)hipMemsetAsync((unsigned char*)d_out + T_BAR, 0, XCD_BAR_WORDS * 4, stream);
    a.ph_lo = 0; a.ph_hi = NPHASE;
    void* args[] = {&a};
    hipError_t e = hipLaunchCooperativeKernel((const void*)mk_fwd, dim3(grid), dim3(512), args, LDS_BYTES, stream);
    if (e != hipSuccess) fprintf(stderr, "cooperative launch failed: %s (grid %d)\n", hipGetErrorString(e), grid);
}
```

```cpp
#include <hip/hip_runtime.h>
#include <hip/hip_cooperative_groups.h>
#include <cstdio>
#include <cstdint>
namespace cg = cooperative_groups;
namespace pg8 {
#define PG8_LAS __attribute__((address_space(3)))
typedef unsigned short bf16_t;
typedef short bf16x8 __attribute__((ext_vector_type(8)));
typedef float f32x4 __attribute__((ext_vector_type(4)));
typedef unsigned u32x4 __attribute__((ext_vector_type(4)));
constexpr int BM = 256, BK = 64, HALF = 128, HTB = HALF * BK * 2  , STAGE_BYTES = 8 * HTB, NXCD = 8, WGM = 8;

__host__ __device__ __forceinline__ int lds_byte(int r, int c) { const int st = (r >> 4) * 2 + (c >> 5), rr = r & 15, cc = c & 31, ob = rr * 64 + cc * 2; return st * 1024 + (ob ^ (((ob >> 9) & 1) << 5)); }
__host__ __device__ __forceinline__ void stage_rc(int b, int& R, int& C) { const int st = b / 1024, sb = b % 1024, swz = sb ^ (((sb >> 9) & 1) << 5); R = (st >> 1) * 16 + swz / 64; C = (st & 1) * 32 + (swz % 64) / 2; }
__host__ __device__ __forceinline__ int perm32(int rho) { const int n = rho >> 4, i = rho & 15; return 8 * (i >> 2) + 4 * n + (i & 3); }

struct Unit { int pm, pn; };
struct Gemm { const bf16_t* A; const bf16_t* Bt; int M, N, K; };

struct StaticOrder {
    int nM, nN, nwg, G, c;
    __host__ __device__ void init(int M, int N, int G_, int c_) { nM = M / BM; nN = N / BM; nwg = nM * nN; G = G_; c = c_; }
    __host__ __device__ bool next(int i, Unit& u) const {
        const long L = (long)i * G + c; if (L >= nwg) return false;
        int wgid = (int)L; { const int q = nwg / NXCD, r = nwg % NXCD, xcd = wgid % NXCD, off = wgid / NXCD; wgid = (xcd < r ? xcd * (q + 1) : r * (q + 1) + (xcd - r) * q) + off; }
        const int nig = WGM * nN, gid = wgid / nig, fm = gid * WGM, gsz = (nM - fm) < WGM ? (nM - fm) : WGM;
        u.pm = fm + ((wgid % nig) % gsz); u.pn = (wgid % nig) / gsz; return true;
    }
    __device__ __forceinline__ void a_ready(const Unit&) const {}
    __device__ __forceinline__ void done(const Unit&) const {}
};

__device__ __forceinline__ unsigned cvt_pk_bf16(float lo, float hi) { unsigned r; asm volatile("v_cvt_pk_bf16_f32 %0, %1, %2" : "=v"(r) : "v"(lo), "v"(hi)); return r; }
typedef float f32x2 __attribute__((ext_vector_type(2)));
__device__ __forceinline__ f32x2 gelu_pk(f32x2 v) {
    const f32x2 av = __builtin_elementwise_abs(v), d = av * 0.2316418882f + 1.0f;
    f32x2 t; t.x = __builtin_amdgcn_rcpf(d.x); t.y = __builtin_amdgcn_rcpf(d.y);
    f32x2 q = t * 0.5307027145f + (-0.7265760135f); q = q * t + 0.7107068705f; q = q * t + (-0.142248368f); q = q * t + 0.127414796f; q = q * t;
    const f32x2 s = (v * v) * (-0.72134752044f);
    f32x2 e; e.x = __builtin_amdgcn_exp2f(s.x); e.y = __builtin_amdgcn_exp2f(s.y);
    const f32x2 m = v * (q * e), r = v - m;
    f32x2 o; o.x = v.x < 0.f ? m.x : r.x; o.y = v.y < 0.f ? m.y : r.y; return o;
}

template <class Epi, class Sched, bool ALIGN_EPI = false, bool SP2 = false>
__device__ __forceinline__ void gemm_phase(PG8_LAS unsigned char* lds, const Gemm g, const Sched& S, const Epi& E) {
    const int tid = threadIdx.x, wid = __builtin_amdgcn_readfirstlane(tid >> 6), lane = tid & 63, wr = wid >> 2, wc = wid & 3, fr = lane & 15, fq = lane >> 4;
    const int K = g.K, nt = K / BK;
    unsigned voffA[2], voffB[2];
#pragma unroll
    for (int i = 0; i < 2; ++i) { int R, C; stage_rc(tid * 16 + i * 8192, R, C); const int Rb = Epi::PERM ? ((R & ~31) + perm32(R & 31)) : R;
        voffA[i] = (unsigned)(R * K + C) * 2u; voffB[i] = (unsigned)(Rb * K + C) * 2u; }
    const size_t kstep = (size_t)(BK * 2);
    const size_t hstep = (size_t)HALF * K * 2;
    const size_t tstep = 2 * hstep;
    const unsigned ldsw = (unsigned)wid * 1024u;
    const int aoff = lds_byte(wr * 64 + fr, fq * 8), boff = lds_byte(wc * 32 + fr, fq * 8);
#define PG8_SA(b, h) (((b) * 2 + (h)) * HTB)
#define PG8_SB(b, h) ((4 + (b) * 2 + (h)) * HTB)
#define PG8_STAGE(bufoff, gbase, voff) do { _Pragma("unroll") for (int _i = 0; _i < 2; ++_i) \
        __builtin_amdgcn_global_load_lds((const unsigned*)((const char*)(gbase) + (voff)[_i]), (PG8_LAS unsigned*)(lds + (bufoff) + ldsw + _i * 8192), 16, 0, 0); } while (0)
#define PG8_LDA(dst, b, h) do { _Pragma("unroll") for (int m = 0; m < 4; ++m) _Pragma("unroll") for (int k = 0; k < 2; ++k) dst[m][k] = *(const PG8_LAS bf16x8*)(lds + PG8_SA(b, h) + aoff + m * 2048 + k * 1024); } while (0)
#define PG8_LDB(dst, b, h) do { _Pragma("unroll") for (int n = 0; n < 2; ++n) _Pragma("unroll") for (int k = 0; k < 2; ++k) dst[n][k] = *(const PG8_LAS bf16x8*)(lds + PG8_SB(b, h) + boff + n * 2048 + k * 1024); } while (0)
#define PG8_MMA(ai, bj, At, Bt) do { __builtin_amdgcn_s_setprio(1); _Pragma("unroll") for (int m = 0; m < 4; ++m) _Pragma("unroll") for (int n = 0; n < 2; ++n) _Pragma("unroll") for (int k = 0; k < 2; ++k) \
        acc[ai][bj][m][n] = __builtin_amdgcn_mfma_f32_16x16x32_bf16(Bt[n][k], At[m][k], acc[ai][bj][m][n], 0, 0, 0); __builtin_amdgcn_s_setprio(0); } while (0)
#define PG8_WAIT_V(n) asm volatile("s_waitcnt vmcnt(" #n ")" ::: "memory")
#define PG8_WAIT_L(n) asm volatile("s_waitcnt lgkmcnt(" #n ")" ::: "memory")
#define PG8_BAR __builtin_amdgcn_s_barrier()
#define PG8_SCHED __builtin_amdgcn_sched_barrier(0)
    Unit cur, nxt; int ui = 0;
    if (!S.next(0, cur)) return;
    f32x4 acc[2][2][4][2];
#pragma unroll
    for (int a = 0; a < 2; ++a)
#pragma unroll
        for (int b = 0; b < 2; ++b)
#pragma unroll
            for (int m = 0; m < 4; ++m)
#pragma unroll
                for (int n = 0; n < 2; ++n) acc[a][b][m][n] = (f32x4){0.f, 0.f, 0.f, 0.f};
    bf16x8 At[4][2], B0[2][2], B1[2][2];
    const char* cA = (const char*)g.A + (size_t)cur.pm * tstep; const char* cB = (const char*)g.Bt + (size_t)cur.pn * tstep;
    S.a_ready(cur);
    if constexpr (SP2) {
        PG8_STAGE(PG8_SB(0, 0), cB, voffB); PG8_STAGE(PG8_SB(0, 1), cB + hstep, voffB); PG8_STAGE(PG8_SA(0, 0), cA, voffA); PG8_STAGE(PG8_SA(0, 1), cA + hstep, voffA);
        if (wr == 1) PG8_BAR;
        PG8_WAIT_V(2); PG8_BAR;
        PG8_STAGE(PG8_SB(1, 0), cB + kstep, voffB); PG8_STAGE(PG8_SA(1, 0), cA + kstep, voffA); PG8_STAGE(PG8_SB(1, 1), cB + hstep + kstep, voffB);
        PG8_WAIT_V(6); PG8_BAR;
    } else {
        PG8_STAGE(PG8_SB(0, 0), cB, voffB); PG8_STAGE(PG8_SA(0, 0), cA, voffA); PG8_STAGE(PG8_SB(0, 1), cB + hstep, voffB); PG8_STAGE(PG8_SA(0, 1), cA + hstep, voffA);
        if (wr == 1) PG8_BAR;
        PG8_WAIT_V(4); PG8_BAR;
        PG8_STAGE(PG8_SB(1, 0), cB + kstep, voffB); PG8_STAGE(PG8_SA(1, 0), cA + kstep, voffA); PG8_STAGE(PG8_SB(1, 1), cB + hstep + kstep, voffB);
        PG8_WAIT_V(6); PG8_BAR;
    }
    for (;;) {
        const bool has_next = S.next(ui + 1, nxt);
        const char* nA = has_next ? (const char*)g.A + (size_t)nxt.pm * tstep : cA; const char* nB = has_next ? (const char*)g.Bt + (size_t)nxt.pn * tstep : cB;
        for (int t = 0; t < nt; t += 2) {
            const bool last = (t == nt - 2);
            const char* a1 = cA + (size_t)(t + 1) * kstep;
            const char* a2 = last ? nA : cA + (size_t)(t + 2) * kstep; const char* b2 = last ? nB : cB + (size_t)(t + 2) * kstep;
            const char* a3 = a2 + kstep; const char* b3 = b2 + kstep;
            if (last && has_next) S.a_ready(nxt);
            if constexpr (SP2) {
            PG8_LDB(B0, 0, 0); PG8_LDB(B1, 0, 1); PG8_SCHED; PG8_LDA(At, 0, 0); PG8_STAGE(PG8_SA(1, 1), a1 + hstep, voffA);
            PG8_WAIT_V(8); PG8_WAIT_L(0); PG8_BAR; PG8_MMA(0, 0, At, B0); PG8_MMA(0, 1, At, B1); PG8_BAR; PG8_SCHED;
            PG8_LDA(At, 0, 1); PG8_STAGE(PG8_SB(0, 0), b2, voffB); PG8_STAGE(PG8_SB(0, 1), b2 + hstep, voffB); PG8_STAGE(PG8_SA(0, 0), a2, voffA);
            PG8_WAIT_V(8); PG8_WAIT_L(0); PG8_BAR; PG8_MMA(1, 0, At, B0); PG8_MMA(1, 1, At, B1); PG8_BAR; PG8_SCHED;
            PG8_LDB(B0, 1, 0); PG8_LDB(B1, 1, 1); PG8_SCHED; PG8_LDA(At, 1, 0); PG8_STAGE(PG8_SA(0, 1), a2 + hstep, voffA);
            PG8_WAIT_V(8); PG8_WAIT_L(0); PG8_BAR; PG8_MMA(0, 0, At, B0); PG8_MMA(0, 1, At, B1); PG8_BAR; PG8_SCHED;
            PG8_LDA(At, 1, 1); PG8_STAGE(PG8_SB(1, 0), b3, voffB); PG8_STAGE(PG8_SB(1, 1), b3 + hstep, voffB); PG8_STAGE(PG8_SA(1, 0), a3, voffA);
            PG8_WAIT_V(8); PG8_WAIT_L(0); PG8_BAR; PG8_MMA(1, 0, At, B0); PG8_MMA(1, 1, At, B1); PG8_BAR; PG8_SCHED;
            } else {
            PG8_LDB(B0, 0, 0); PG8_SCHED; PG8_LDA(At, 0, 0); PG8_STAGE(PG8_SA(1, 1), a1 + hstep, voffA);
            PG8_WAIT_L(8); PG8_BAR; PG8_WAIT_L(0); PG8_MMA(0, 0, At, B0); PG8_BAR; PG8_SCHED;
            PG8_LDB(B1, 0, 1); PG8_STAGE(PG8_SB(0, 0), b2, voffB);
            PG8_BAR; PG8_WAIT_L(0); PG8_MMA(0, 1, At, B1); PG8_BAR;
            PG8_LDA(At, 0, 1); PG8_STAGE(PG8_SA(0, 0), a2, voffA);
            PG8_BAR; PG8_WAIT_L(0); PG8_MMA(1, 0, At, B0); PG8_BAR; PG8_SCHED;
            PG8_STAGE(PG8_SB(0, 1), b2 + hstep, voffB);
            PG8_WAIT_V(6); PG8_BAR; PG8_MMA(1, 1, At, B1); PG8_BAR;
            PG8_LDB(B0, 1, 0); PG8_SCHED; PG8_LDA(At, 1, 0); PG8_STAGE(PG8_SA(0, 1), a2 + hstep, voffA);
            PG8_WAIT_L(8); PG8_BAR; PG8_WAIT_L(0); PG8_MMA(0, 0, At, B0); PG8_BAR; PG8_SCHED;
            PG8_LDB(B1, 1, 1); PG8_STAGE(PG8_SB(1, 0), b3, voffB);
            PG8_BAR; PG8_WAIT_L(0); PG8_MMA(0, 1, At, B1); PG8_BAR;
            PG8_LDA(At, 1, 1); PG8_STAGE(PG8_SA(1, 0), a3, voffA);
            PG8_BAR; PG8_WAIT_L(0); PG8_MMA(1, 0, At, B0); PG8_BAR; PG8_SCHED;
            PG8_STAGE(PG8_SB(1, 1), b3 + hstep, voffB);
            PG8_WAIT_V(6); PG8_BAR; PG8_MMA(1, 1, At, B1); PG8_BAR;
            }
        }
        if constexpr (ALIGN_EPI) { if (wr == 0) PG8_BAR; }
        if constexpr (!Epi::AFTER_DRAIN) { E(acc, cur, wr, wc, fr, fq); S.done(cur); }
        if (!has_next) break;
#pragma unroll
        for (int a = 0; a < 2; ++a)
#pragma unroll
            for (int b = 0; b < 2; ++b)
#pragma unroll
                for (int m = 0; m < 4; ++m)
#pragma unroll
                    for (int n = 0; n < 2; ++n) acc[a][b][m][n] = (f32x4){0.f, 0.f, 0.f, 0.f};
        cur = nxt; cA = nA; cB = nB; ++ui;
        if constexpr (ALIGN_EPI) { if (wr == 1) PG8_BAR; }
    }
    PG8_WAIT_V(0);
    if constexpr (!ALIGN_EPI) { if (wr == 0) PG8_BAR; }
    PG8_BAR;
    if constexpr (Epi::AFTER_DRAIN) { E.fused(acc, cur, wr, wc, fr, fq, lds, wid, lane); S.done(cur); }
#undef PG8_SA
#undef PG8_SB
#undef PG8_STAGE
#undef PG8_LDA
#undef PG8_LDB
#undef PG8_MMA
#undef PG8_WAIT_V
#undef PG8_WAIT_L
#undef PG8_BAR
#undef PG8_SCHED
}
}

using pg8::bf16_t; using pg8::bf16x8; using pg8::f32x4; using pg8::u32x4; using pg8::f32x2; using pg8::cvt_pk_bf16;
#define LAS __attribute__((address_space(3)))
#define DI __device__ __forceinline__
typedef float f32x16 __attribute__((ext_vector_type(16)));
typedef unsigned u32x2 __attribute__((ext_vector_type(2)));
typedef float f32x2v __attribute__((ext_vector_type(2)));
typedef _Float16 h16x4 __attribute__((ext_vector_type(4)));
typedef _Float16 h16x2 __attribute__((ext_vector_type(2)));

#define XB_TMO      128
#define XB_XCNT(j)  (256  + 64 * (j))
#define XB_XSUB(j)  (1280 + 64 * (j))
#define XB_XGEN(j)  (2304 + 64 * (j))
#define XB_TOP      3328
#define XB_TOPGEN   3392
#define XCD_BAR_WORDS 3456
#define XB_SPIN_CAP (1u << 18)

__device__ __forceinline__ unsigned xb_ld(unsigned* p)              { return __hip_atomic_load(p, __ATOMIC_RELAXED, __HIP_MEMORY_SCOPE_AGENT); }
__device__ __forceinline__ unsigned xb_add(unsigned* p, unsigned v) { return __hip_atomic_fetch_add(p, v, __ATOMIC_RELAXED, __HIP_MEMORY_SCOPE_AGENT); }
__device__ __forceinline__ unsigned xb_xcc_id() { return (unsigned)__builtin_amdgcn_s_getreg((3 << 11) | 20) & 0xFu; }
#define XB_SPIN(cond, bar) do { unsigned _sp = 0; while (cond) { __builtin_amdgcn_s_sleep(1); \
    if ((++_sp & 255u) == 0u) { if (xb_ld(&(bar)[XB_TMO])) break; if (_sp > XB_SPIN_CAP) { atomicAdd(&(bar)[XB_TMO], 1u); break; } } } } while (0)

struct XcdBarrier {
    unsigned* bar; unsigned x;
    volatile LAS unsigned* st;
};

__device__ __forceinline__ XcdBarrier xcd_barrier_post(unsigned* bar, volatile LAS unsigned* st) {
    XcdBarrier b; b.bar = bar; b.x = xb_xcc_id(); b.st = st;
    if (threadIdx.x == 0) (void)xb_add(&bar[XB_XCNT(b.x)], 1u);
    return b;
}
__device__ __forceinline__ void xcd_barrier_complete(unsigned* bar, unsigned x, unsigned& nloc, unsigned& nx) {
    const unsigned G = gridDim.x * gridDim.y * gridDim.z;
    unsigned sum, cnt, mine, sp = 0u;
    for (;;) {
        sum = 0u; cnt = 0u; mine = 0u;
#pragma unroll
        for (unsigned j = 0; j < 16; ++j) { const unsigned c = xb_ld(&bar[XB_XCNT(j)]); sum += c; cnt += (c > 0u) ? 1u : 0u; mine = (j == x) ? c : mine; }
        if (sum == G) break;
        __builtin_amdgcn_s_sleep(1);
        if ((++sp & 255u) == 0u) { if (xb_ld(&bar[XB_TMO])) break; if (sp > XB_SPIN_CAP) { atomicAdd(&bar[XB_TMO], 1u); break; } }
    }
    nloc = mine > 0u ? mine : 1u; nx = cnt > 0u ? cnt : 1u;
}

__device__ __forceinline__ void xcd_barrier(const XcdBarrier& b) {
    asm volatile("s_waitcnt vmcnt(0)" ::: "memory");
    __syncthreads();
    if (threadIdx.x == 0) {
        unsigned* bar = b.bar;
        __builtin_amdgcn_s_waitcnt(0);
        unsigned nloc = b.st[0], nx = b.st[1];
        if (nloc == 0u) { xcd_barrier_complete(bar, b.x, nloc, nx); b.st[0] = nloc; b.st[1] = nx; }
        const unsigned old = xb_add(&bar[XB_XSUB(b.x)], 1u);
        const unsigned gen = old / nloc;
        if (old + 1u == (gen + 1u) * nloc) {
            __builtin_amdgcn_fence(__ATOMIC_RELEASE, "agent");
            asm volatile("s_waitcnt vmcnt(0)" ::: "memory");
            const unsigned og = xb_add(&bar[XB_TOP], 1u);
            const unsigned tg = og / nx;
            if (og + 1u == (tg + 1u) * nx) xb_add(&bar[XB_TOPGEN], 1u);
            else XB_SPIN(xb_ld(&bar[XB_TOPGEN]) == tg, bar);
            __builtin_amdgcn_fence(__ATOMIC_ACQUIRE, "agent");
            xb_add(&bar[XB_XGEN(b.x)], 1u);
            asm volatile("s_waitcnt vmcnt(0)" ::: "memory");
        } else {
            XB_SPIN(xb_ld(&bar[XB_XGEN(b.x)]) == gen, bar);
            __builtin_amdgcn_fence(__ATOMIC_ACQUIRE, "agent");
            asm volatile("s_waitcnt vmcnt(0)" ::: "memory");
        }
    }
    __syncthreads();
}


constexpr int BATCH = 8, SEQ = 4096, D = 2048, M = BATCH * SEQ;
constexpr int HG_N = 8192, NHEAD = 16;
constexpr int SG_N = 4096;
constexpr int DFF = 5632, UP_N = 2 * DFF;
constexpr float ALPHA = 1.41421356237309515f;
constexpr float LN_EPS = 1e-5f, RMS_EPS = 1e-6f;
constexpr int NPHASE = 14;

constexpr size_t MiB = 1u << 20;
constexpr size_t WS_W_HGIN = 0, WS_W_HGOUT = 32 * MiB, WS_W_SGIN = 40 * MiB, WS_W_SGOUT = 56 * MiB;
constexpr size_t WS_W_UP0 = 64 * MiB, WS_W_UP1 = 108 * MiB, WS_W_DN0 = 152 * MiB, WS_W_DN1 = 174 * MiB;
constexpr size_t WS_XB = 196 * MiB;
constexpr size_t WS_Q = 324 * MiB, WS_V = 452 * MiB, WS_GT = 580 * MiB, WS_LF = 708 * MiB;
constexpr size_t WS_H = 768 * MiB;
constexpr size_t WS_GH = 324 * MiB, WS_FA = 676 * MiB, WS_FB = 720 * MiB;
constexpr size_t T_LB = 0;
constexpr size_t T_STAT = 1 * MiB;
constexpr size_t T_WSB = 2 * MiB;
constexpr size_t T_CS = 3 * MiB;
constexpr size_t T_CS_UP0 = T_CS, T_CS_SGIN = T_CS + 2 * 11264 * 4, T_CS_UP1 = T_CS_SGIN + 2 * 4096 * 4;
constexpr size_t T_STATV = 4 * MiB;
constexpr size_t T_ZERO_LO = 1 * MiB, T_ZERO_HI = 5 * MiB;
constexpr size_t T_BAR = 250 * MiB;
constexpr size_t WS_U = 324 * MiB, WS_VV = 452 * MiB;
constexpr size_t WS_ST3 = 1000 * MiB;
constexpr size_t WS_NEED = 1024 * MiB;
constexpr int LDS_BYTES = 139520, LDS_BARST = 139264;

struct Args { const float* in[19]; float* out; unsigned char* ws; int ph_lo, ph_hi; };
#define TMP_(a, off) ((unsigned char*)(a).out + (off))

DI float bf_lo(unsigned u) { return __uint_as_float(u << 16); }
DI float bf_hi(unsigned u) { return __uint_as_float(u & 0xffff0000u); }
DI float silu_f(float x) { return x * __builtin_amdgcn_rcpf(1.0f + __expf(-x)); }
DI float wave_sum(float v) {
#pragma unroll
    for (int o = 1; o < 64; o <<= 1) v += __shfl_xor(v, o);
    return v;
}
#define LDS_WAIT() asm volatile("s_waitcnt lgkmcnt(0)" ::: "memory")

DI void row_stats(const float* st, int row, float& mu, float& rs) {
    const f32x2v sv = *(const f32x2v*)(st + 2 * (size_t)row);
    mu = sv.x * (1.0f / D); const float var = fmaxf(sv.y * (1.0f / D) - mu * mu, 0.f); rs = rsqrtf(var + LN_EPS);
}
template <int RESMODE, bool LAST>
struct EpiRes {
    static constexpr bool PERM = true, AFTER_DRAIN = false;
    const float* res32; float* out; bf16_t* xb; const float* st_prev; float* st_new; const float* g; const float* b;
    DI void operator()(const f32x4 (&acc)[2][2][4][2], const pg8::Unit& u, int wr, int wc, int fr, int fq) const {
        const int row0 = u.pm * 256 + wr * 64 + fr, col0 = u.pn * 256 + wc * 32 + 8 * fq;
        f32x4 gv[2][2], bv[2][2];
        if (RESMODE) {
#pragma unroll
            for (int bj = 0; bj < 2; ++bj)
#pragma unroll
                for (int n = 0; n < 2; ++n) { gv[bj][n] = *(const f32x4*)(g + col0 + bj * 128 + 4 * n); bv[bj][n] = *(const f32x4*)(b + col0 + bj * 128 + 4 * n); }
        }
        constexpr int NB = 4;
#pragma unroll
        for (int ab = 0; ab < 8 / NB; ++ab) {
            const int ai = (ab * NB) >> 2, mb = (ab * NB) & 3;
            f32x4 rv[4][2][2]; u32x4 rb[4][2]; f32x2v sv[4];
#pragma unroll
            for (int m = mb; m < mb + NB; ++m) {
                const int row = row0 + ai * 128 + m * 16;
                const size_t off = (size_t)row * D + col0;
                if (RESMODE) {
                    sv[m] = *(const f32x2v*)(st_prev + 2 * (size_t)row);
#pragma unroll
                    for (int bj = 0; bj < 2; ++bj) rb[m][bj] = *(const u32x4*)(xb + off + bj * 128);
                } else {
#pragma unroll
                    for (int bj = 0; bj < 2; ++bj)
#pragma unroll
                        for (int n = 0; n < 2; ++n) rv[m][bj][n] = *(const f32x4*)(res32 + off + bj * 128 + 4 * n);
                }
            }
#pragma unroll
            for (int m = mb; m < mb + NB; ++m) {
                const int row = row0 + ai * 128 + m * 16;
                const size_t off = (size_t)row * D + col0;
                float mu = 0.f, rs = 1.f;
                if (RESMODE) { mu = sv[m].x * (1.0f / D); const float var = fmaxf(sv[m].y * (1.0f / D) - mu * mu, 0.f); rs = rsqrtf(var + LN_EPS); }
                float s = 0.f, s2 = 0.f;
#pragma unroll
                for (int bj = 0; bj < 2; ++bj) {
                    f32x4 y[2];
#pragma unroll
                    for (int n = 0; n < 2; ++n) {
                        f32x4 r;
                        if (RESMODE) {
                            const unsigned w0 = n ? rb[m][bj].z : rb[m][bj].x, w1 = n ? rb[m][bj].w : rb[m][bj].y;
                            r = (f32x4){bf_lo(w0), bf_hi(w0), bf_lo(w1), bf_hi(w1)};
                            r = (r - mu) * rs * gv[bj][n] + bv[bj][n];
                        } else r = rv[m][bj][n];
                        y[n] = r * ALPHA + acc[ai][bj][m][n];
                        if (LAST) *(f32x4*)(out + off + bj * 128 + 4 * n) = y[n];
                        s += (y[n][0] + y[n][1]) + (y[n][2] + y[n][3]);
                        s2 += (y[n][0] * y[n][0] + y[n][1] * y[n][1]) + (y[n][2] * y[n][2] + y[n][3] * y[n][3]);
                    }
                    if (!LAST) {
                        u32x4 w; w.x = cvt_pk_bf16(y[0][0], y[0][1]); w.y = cvt_pk_bf16(y[0][2], y[0][3]); w.z = cvt_pk_bf16(y[1][0], y[1][1]); w.w = cvt_pk_bf16(y[1][2], y[1][3]);
                        *(u32x4*)(xb + off + bj * 128) = w;
                    }
                }
                if (!LAST) {
                    s += __shfl_xor(s, 16); s += __shfl_xor(s, 32); s2 += __shfl_xor(s2, 16); s2 += __shfl_xor(s2, 32);
                    if (fq == 0) {
                        __hip_atomic_fetch_add(st_new + 2 * (size_t)row, s, __ATOMIC_RELAXED, __HIP_MEMORY_SCOPE_AGENT);
                        __hip_atomic_fetch_add(st_new + 2 * (size_t)row + 1, s2, __ATOMIC_RELAXED, __HIP_MEMORY_SCOPE_AGENT);
                    }
                }
            }
            asm volatile("" ::: "memory");
        }
    }
};

struct EpiHgProj {
    static constexpr bool PERM = true, AFTER_DRAIN = false;
    unsigned char* ws; const float* lb;
    DI void operator()(const f32x4 (&acc)[2][2][4][2], const pg8::Unit& u, int wr, int wc, int fr, int fq) const {
        const int sec = u.pn >> 3, colt = (u.pn & 7) * 256;
        const int row0 = u.pm * 256 + wr * 64 + fr, col0 = colt + wc * 32 + 8 * fq;
        if (sec == 1) {
            f32x4 lbv[2][2];
#pragma unroll
            for (int bj = 0; bj < 2; ++bj)
#pragma unroll
                for (int n = 0; n < 2; ++n) lbv[bj][n] = *(const f32x4*)(lb + col0 + bj * 128 + 4 * n);
#pragma unroll
            for (int ai = 0; ai < 2; ++ai)
#pragma unroll
                for (int m = 0; m < 4; ++m) {
                    _Float16* rowp = (_Float16*)(ws + WS_LF) + (size_t)(row0 + ai * 128 + m * 16) * D + col0;
#pragma unroll
                    for (int bj = 0; bj < 2; ++bj)
#pragma unroll
                        for (int n = 0; n < 2; ++n) {
                            h16x4 o;
#pragma unroll
                            for (int j = 0; j < 4; ++j) {
                                const float x = acc[ai][bj][m][n][j], l = lbv[bj][n][j];
                                const float sg = __builtin_amdgcn_rcpf(1.0f + __expf(-x));
                                o[j] = (_Float16)(l + (1.0f - l) * sg);
                            }
                            __builtin_nontemporal_store(o, (h16x4*)(rowp + bj * 128 + 4 * n));
                        }
                }
        } else {
            bf16_t* base = (bf16_t*)(ws + (sec == 0 ? WS_Q : (sec == 2 ? WS_V : WS_GT)));
            const bool act = (sec != 2);
#pragma unroll
            for (int ai = 0; ai < 2; ++ai)
#pragma unroll
                for (int m = 0; m < 4; ++m) {
                    bf16_t* rowp = base + (size_t)(row0 + ai * 128 + m * 16) * D + col0;
#pragma unroll
                    for (int bj = 0; bj < 2; ++bj) {
                        f32x4 v0 = acc[ai][bj][m][0], v1 = acc[ai][bj][m][1];
                        if (act) {
#pragma unroll
                            for (int j = 0; j < 4; ++j) { v0[j] = silu_f(v0[j]); v1[j] = silu_f(v1[j]); }
                        }
                        u32x4 w; w.x = cvt_pk_bf16(v0[0], v0[1]); w.y = cvt_pk_bf16(v0[2], v0[3]); w.z = cvt_pk_bf16(v1[0], v1[1]); w.w = cvt_pk_bf16(v1[2], v1[3]);
                        __builtin_nontemporal_store(w, (u32x4*)(rowp + bj * 128));
                    }
                }
        }
    }
};

struct EpiGelu {
    static constexpr bool PERM = true, AFTER_DRAIN = false;
    bf16_t* U; bf16_t* VV; const float* st; const float* cs; float* stv;
    DI void operator()(const f32x4 (&acc)[2][2][4][2], const pg8::Unit& u, int wr, int wc, int fr, int fq) const {
        bf16_t* base = (u.pn >> 3) ? VV : U;
        const int colt = (u.pn & 7) * 256;
        const int row0 = u.pm * 256 + wr * 64 + fr, col0 = colt + wc * 32 + 8 * fq;
        const int gcol = u.pn * 256 + wc * 32 + 8 * fq;
        f32x4 c1[2][2], c2[2][2];
#pragma unroll
        for (int bj = 0; bj < 2; ++bj)
#pragma unroll
            for (int n = 0; n < 2; ++n) { c1[bj][n] = *(const f32x4*)(cs + gcol + bj * 128 + 4 * n); c2[bj][n] = *(const f32x4*)(cs + SG_N + gcol + bj * 128 + 4 * n); }
        float mus[2][4], rss[2][4];
#pragma unroll
        for (int ai = 0; ai < 2; ++ai)
#pragma unroll
            for (int m = 0; m < 4; ++m) row_stats(st, row0 + ai * 128 + m * 16, mus[ai][m], rss[ai][m]);
#pragma unroll
        for (int ai = 0; ai < 2; ++ai)
#pragma unroll
            for (int m = 0; m < 4; ++m) {
                bf16_t* rowp = base + (size_t)(row0 + ai * 128 + m * 16) * D + col0;
                const float mu = mus[ai][m], rs = rss[ai][m];
                float vs = 0.f, vs2 = 0.f;
#pragma unroll
                for (int bj = 0; bj < 2; ++bj) {
                    const f32x4 v0 = (acc[ai][bj][m][0] - c1[bj][0] * mu) * rs + c2[bj][0], v1 = (acc[ai][bj][m][1] - c1[bj][1] * mu) * rs + c2[bj][1];
                    const f32x2 a = pg8::gelu_pk((f32x2){v0[0], v0[1]}), b = pg8::gelu_pk((f32x2){v0[2], v0[3]}), c = pg8::gelu_pk((f32x2){v1[0], v1[1]}), d = pg8::gelu_pk((f32x2){v1[2], v1[3]});
                    u32x4 w; w.x = cvt_pk_bf16(a.x, a.y); w.y = cvt_pk_bf16(b.x, b.y); w.z = cvt_pk_bf16(c.x, c.y); w.w = cvt_pk_bf16(d.x, d.y);
                    *(u32x4*)(rowp + bj * 128) = w;
                    vs += ((a.x + a.y) + (b.x + b.y)) + ((c.x + c.y) + (d.x + d.y));
                    vs2 += ((a.x * a.x + a.y * a.y) + (b.x * b.x + b.y * b.y)) + ((c.x * c.x + c.y * c.y) + (d.x * d.x + d.y * d.y));
                }
                if (u.pn >> 3) {
                    vs += __shfl_xor(vs, 16); vs += __shfl_xor(vs, 32); vs2 += __shfl_xor(vs2, 16); vs2 += __shfl_xor(vs2, 32);
                    if (fq == 0) {
                        const size_t row = (size_t)(row0 + ai * 128 + m * 16);
                        __hip_atomic_fetch_add(stv + 2 * row, vs, __ATOMIC_RELAXED, __HIP_MEMORY_SCOPE_AGENT);
                        __hip_atomic_fetch_add(stv + 2 * row + 1, vs2, __ATOMIC_RELAXED, __HIP_MEMORY_SCOPE_AGENT);
                    }
                }
            }
    }
};

struct EpiUp {
    static constexpr bool PERM = true, AFTER_DRAIN = false;
    bf16_t* GH; float* FA; float* FB; const float* cw; const float* cb; const float* st; const float* cs;
    DI void operator()(const f32x4 (&acc)[2][2][4][2], const pg8::Unit& u, int wr, int wc, int fr, int fq) const {
        const int lane = threadIdx.x & 63;
        const int src1 = (lane & 48) | ((lane - 1) & 15), src2 = (lane & 48) | ((lane - 2) & 15);
        u32x2 keep[2][4];
        float mus[2][4], rss[2][4];
#pragma unroll
        for (int ai = 0; ai < 2; ++ai)
#pragma unroll
            for (int m = 0; m < 4; ++m) row_stats(st, u.pm * 256 + ai * 128 + wr * 64 + m * 16 + fr, mus[ai][m], rss[ai][m]);
#pragma unroll
        for (int n = 0; n < 2; ++n) {
            const int colg = u.pn * 128 + wc * 32 + 8 * fq + 4 * n;
            const int gcol = u.pn * 256 + wc * 32 + 8 * fq + 4 * n;
            const f32x4 w0 = *(const f32x4*)(cw + colg), w1 = *(const f32x4*)(cw + DFF + colg), w2 = *(const f32x4*)(cw + 2 * DFF + colg), bb = *(const f32x4*)(cb + colg);
            const f32x4 c1a = *(const f32x4*)(cs + gcol), c2a = *(const f32x4*)(cs + UP_N + gcol), c1b = *(const f32x4*)(cs + gcol + 128), c2b = *(const f32x4*)(cs + UP_N + gcol + 128);
#pragma unroll
            for (int ai = 0; ai < 2; ++ai) {
                const int blk = u.pm * 4 + ai * 2 + wr;
                f32x4 q1 = {0.f, 0.f, 0.f, 0.f}, q2 = {0.f, 0.f, 0.f, 0.f};
#pragma unroll
                for (int m = 0; m < 4; ++m) {
                    const int row = u.pm * 256 + ai * 128 + wr * 64 + m * 16 + fr;
                    const float mu = mus[ai][m], rs = rss[ai][m];
                    const f32x4 av = (acc[ai][0][m][n] - c1a * mu) * rs + c2a;
                    const f32x4 bv = (acc[ai][1][m][n] - c1b * mu) * rs + c2b;
                    f32x4 p1, p2;
#pragma unroll
                    for (int j = 0; j < 4; ++j) {
                        const float r1 = __int_as_float(__builtin_amdgcn_update_dpp(0, __float_as_int(av[j]), 0x121, 0xf, 0xf, false));
                        const float r2 = __int_as_float(__builtin_amdgcn_update_dpp(0, __float_as_int(av[j]), 0x122, 0xf, 0xf, false));
                        p1[j] = fr >= 1 ? r1 : q1[j]; p2[j] = fr >= 2 ? r2 : q2[j];
                        q1[j] = r1; q2[j] = r2;
                    }
                    const f32x4 cv = w2 * av + (w1 * p1 + (w0 * p2 + bb));
                    const f32x4 ex = cv * (-1.44269504088896341f);
                    f32x4 den; den[0] = __builtin_amdgcn_exp2f(ex[0]); den[1] = __builtin_amdgcn_exp2f(ex[1]); den[2] = __builtin_amdgcn_exp2f(ex[2]); den[3] = __builtin_amdgcn_exp2f(ex[3]);
                    den = den + 1.0f;
                    f32x4 rc; rc[0] = __builtin_amdgcn_rcpf(den[0]); rc[1] = __builtin_amdgcn_rcpf(den[1]); rc[2] = __builtin_amdgcn_rcpf(den[2]); rc[3] = __builtin_amdgcn_rcpf(den[3]);
                    const f32x4 o = (cv * rc) * bv;
                    u32x2 w; w.x = cvt_pk_bf16(o[0], o[1]); w.y = cvt_pk_bf16(o[2], o[3]);
                    if (n == 0) keep[ai][m] = w;
                    else __builtin_nontemporal_store((u32x4){keep[ai][m].x, keep[ai][m].y, w.x, w.y}, (u32x4*)(GH + (size_t)row * DFF + colg - 4));
                    if (m == 0 && fr < 2) {
                        __builtin_nontemporal_store(av, (f32x4*)(FA + (size_t)(blk * 4 + 2 + fr) * DFF + colg));
                        __builtin_nontemporal_store(bv, (f32x4*)(FB + (size_t)(blk * 2 + fr) * DFF + colg));
                    }
                    if (m == 3 && fr >= 14) __builtin_nontemporal_store(av, (f32x4*)(FA + (size_t)(blk * 4 + (fr - 14)) * DFF + colg));
                }
            }
            asm volatile("" ::: "memory");
        }
    }
};

template <int MODE  , bool FOLD>
DI void transpose_item(const float* W, int K, int N, bf16_t* WT, LAS float* scr, int item, int lane, const float* lg, const float* lbv, float* cs) {
    const int nblk = N / 32, kb = item / nblk, nb = item % nblk, k0 = 64 * kb, n0 = 32 * nb;
    {
        const int krow = lane >> 3, n4 = (lane & 7) * 4;
        f32x4 t[8];
#pragma unroll
        for (int i = 0; i < 8; ++i) t[i] = *(const f32x4*)(W + (size_t)(k0 + 8 * i + krow) * N + n0 + n4);
#pragma unroll
        for (int i = 0; i < 8; ++i) { LAS float* d = scr + (8 * i + krow) * 33 + n4; d[0] = t[i][0]; d[1] = t[i][1]; d[2] = t[i][2]; d[3] = t[i][3]; }
    }
    LDS_WAIT();
    const int c = lane & 7;
    int r0 = n0;
    if (MODE == 1) r0 = (n0 < DFF) ? ((n0 >> 7) * 256 + (n0 & 127)) : (((n0 - DFF) >> 7) * 256 + 128 + ((n0 - DFF) & 127));
    float gk[8], bk[8];
    if (FOLD) {
        const f32x4 g0 = *(const f32x4*)(lg + k0 + 8 * c), g1 = *(const f32x4*)(lg + k0 + 8 * c + 4), b0 = *(const f32x4*)(lbv + k0 + 8 * c), b1 = *(const f32x4*)(lbv + k0 + 8 * c + 4);
#pragma unroll
        for (int i = 0; i < 4; ++i) { gk[i] = g0[i]; gk[4 + i] = g1[i]; bk[i] = b0[i]; bk[4 + i] = b1[i]; }
    }
#pragma unroll
    for (int j = 0; j < 4; ++j) {
        const int n = (lane >> 3) + 8 * j; const LAS float* s = scr + (8 * c) * 33 + n;
        float v[8]; float t1 = 0.f;
#pragma unroll
        for (int i = 0; i < 8; ++i) { v[i] = s[i * 33]; if (FOLD) { t1 += v[i] * bk[i]; v[i] *= gk[i]; } }
        u32x4 o; o.x = cvt_pk_bf16(v[0], v[1]); o.y = cvt_pk_bf16(v[2], v[3]); o.z = cvt_pk_bf16(v[4], v[5]); o.w = cvt_pk_bf16(v[6], v[7]);
        *(u32x4*)(WT + (size_t)(r0 + n) * K + k0 + 8 * c) = o;
        if (FOLD) {
            float t0 = ((bf_lo(o.x) + bf_hi(o.x)) + (bf_lo(o.y) + bf_hi(o.y))) + ((bf_lo(o.z) + bf_hi(o.z)) + (bf_lo(o.w) + bf_hi(o.w)));
            t0 += __shfl_xor(t0, 1); t0 += __shfl_xor(t0, 2); t0 += __shfl_xor(t0, 4);
            t1 += __shfl_xor(t1, 1); t1 += __shfl_xor(t1, 2); t1 += __shfl_xor(t1, 4);
            if (c == 0) {
                __hip_atomic_fetch_add(cs + r0 + n, t0, __ATOMIC_RELAXED, __HIP_MEMORY_SCOPE_AGENT);
                __hip_atomic_fetch_add(cs + N + r0 + n, t1, __ATOMIC_RELAXED, __HIP_MEMORY_SCOPE_AGENT);
            }
        }
    }
    LDS_WAIT();
}

DI void prologue_phase(const Args& a, LAS unsigned char* lds) {
    const int tid = threadIdx.x, lane = tid & 63, wave = tid >> 6;
    const int G = gridDim.x, gw = blockIdx.x * 8 + wave, NGW = G * 8;
    unsigned char* ws = a.ws;
    LAS float* scr = (LAS float*)(lds + wave * 8704);
    constexpr int I_HGIN = 32 * (HG_N / 32);
    for (int it = gw; it < I_HGIN; it += NGW) transpose_item<0, false>(a.in[2], D, HG_N, (bf16_t*)(ws + WS_W_HGIN), scr, it, lane, nullptr, nullptr, nullptr);
    const size_t gt = (size_t)blockIdx.x * 512 + tid, NT = (size_t)G * 512;
    {
        const float* x = a.in[0]; bf16_t* xb = (bf16_t*)(ws + WS_XB);
        for (size_t i = gt; i < (size_t)M * D / 8; i += 4 * NT) {
            f32x4 v0[4], v1[4];
#pragma unroll
            for (int k = 0; k < 4; ++k) { const size_t j = i + (size_t)k * NT; if (j < (size_t)M * D / 8) { v0[k] = *(const f32x4*)(x + j * 8); v1[k] = *(const f32x4*)(x + j * 8 + 4); } }
#pragma unroll
            for (int k = 0; k < 4; ++k) { const size_t j = i + (size_t)k * NT; if (j < (size_t)M * D / 8) {
                u32x4 w; w.x = cvt_pk_bf16(v0[k][0], v0[k][1]); w.y = cvt_pk_bf16(v0[k][2], v0[k][3]); w.z = cvt_pk_bf16(v1[k][0], v1[k][1]); w.w = cvt_pk_bf16(v1[k][2], v1[k][3]);
                *(u32x4*)(xb + j * 8) = w; } }
        }
    }
    {
        u32x4* z0 = (u32x4*)TMP_(a, T_ZERO_LO); u32x4* z1 = (u32x4*)(ws + WS_ST3);
        const u32x4 zero = {0u, 0u, 0u, 0u};
        for (size_t i = gt; i < (T_ZERO_HI - T_ZERO_LO) / 16; i += NT) z0[i] = zero;
        for (size_t i = gt; i < (size_t)M * 8 / 16; i += NT) z1[i] = zero;
    }
    {
        const float* l = a.in[1]; float* lb = (float*)TMP_(a, T_LB);
        for (size_t i = gt; i < (size_t)D; i += NT) {
            const float l0 = l[i], l1 = l[D + i], l2 = l[2 * D + i];
            const float mx = fmaxf(l0, fmaxf(l1, l2));
            const float e0 = expf(l0 - mx), e1 = expf(l1 - mx), e2 = expf(l2 - mx);
            lb[i] = e0 / (e0 + e1 + e2);
        }
    }
}
DI void convert_rest(const Args& a, LAS unsigned char* lds, int gw, int NGW) {
    const int lane = threadIdx.x & 63, wave = threadIdx.x >> 6;
    unsigned char* ws = a.ws;
    LAS float* scr = (LAS float*)(lds + wave * 8704);
    constexpr int I_SQ = 32 * (D / 32), I_SGIN = 32 * (SG_N / 32), I_UP = 32 * (UP_N / 32), I_DN = (DFF / 64) * (D / 32);
    constexpr int NITEMS = 2 * I_SQ + I_SGIN + 2 * I_UP + 2 * I_DN;
    for (int it = gw; it < NITEMS; it += NGW) {
        int r = it;
        if (r < I_SQ) { transpose_item<0, false>(a.in[4], D, D, (bf16_t*)(ws + WS_W_HGOUT), scr, r, lane, nullptr, nullptr, nullptr); continue; } r -= I_SQ;
        if (r < I_UP) { transpose_item<1, true>(a.in[11], D, UP_N, (bf16_t*)(ws + WS_W_UP0), scr, r, lane, a.in[15], a.in[16], (float*)TMP_(a, T_CS_UP0)); continue; } r -= I_UP;
        if (r < I_DN) { transpose_item<0, false>(a.in[14], DFF, D, (bf16_t*)(ws + WS_W_DN0), scr, r, lane, nullptr, nullptr, nullptr); continue; } r -= I_DN;
        if (r < I_SGIN) { transpose_item<0, true>(a.in[5], D, SG_N, (bf16_t*)(ws + WS_W_SGIN), scr, r, lane, a.in[17], a.in[18], (float*)TMP_(a, T_CS_SGIN)); continue; } r -= I_SGIN;
        if (r < I_SQ) { transpose_item<0, false>(a.in[10], D, D, (bf16_t*)(ws + WS_W_SGOUT), scr, r, lane, nullptr, nullptr, nullptr); continue; } r -= I_SQ;
        if (r < I_UP) { transpose_item<1, true>(a.in[11] + (size_t)D * UP_N, D, UP_N, (bf16_t*)(ws + WS_W_UP1), scr, r, lane, a.in[15] + D, a.in[16] + D, (float*)TMP_(a, T_CS_UP1)); continue; } r -= I_UP;
        transpose_item<0, false>(a.in[14] + (size_t)DFF * D, DFF, D, (bf16_t*)(ws + WS_W_DN1), scr, r, lane, nullptr, nullptr, nullptr);
    }
}

DI void wsb_phase(const Args& a, size_t gt, size_t NT) {
    const float* w = a.in[8]; bf16_t* wb = (bf16_t*)TMP_(a, T_WSB);
    for (size_t i = gt; i < (size_t)16 * 128 * 128 / 2; i += NT) {
        const size_t e = i * 2; const int s = (int)(e & 127), t = (int)((e >> 7) & 127);
        const float v0 = (s <= t) ? w[e] : 0.f, v1 = (s + 1 <= t) ? w[e + 1] : 0.f;
        *(unsigned*)(wb + e) = cvt_pk_bf16(v0, v1);
    }
}

DI void ln_phase(const float* Y, float* Hout, bf16_t* XB, const float* g, const float* b) {
    const int tid = threadIdx.x, lane = tid & 63, wave = tid >> 6;
    const int gw = blockIdx.x * 8 + wave, NGW = gridDim.x * 8;
    for (int row = gw; row < M; row += NGW) {
        const f32x4* yr = (const f32x4*)(Y + (size_t)row * D) + lane;
        f32x4 v[8]; float s = 0.f;
#pragma unroll
        for (int j = 0; j < 8; ++j) { v[j] = yr[64 * j]; s += (v[j][0] + v[j][1]) + (v[j][2] + v[j][3]); }
        const float mean = wave_sum(s) * (1.0f / D); float s2 = 0.f;
#pragma unroll
        for (int j = 0; j < 8; ++j) { v[j] = v[j] - mean; s2 += (v[j][0] * v[j][0] + v[j][1] * v[j][1]) + (v[j][2] * v[j][2] + v[j][3] * v[j][3]); }
        const float rstd = rsqrtf(wave_sum(s2) * (1.0f / D) + LN_EPS);
        f32x4* ho = (f32x4*)(Hout + (size_t)row * D) + lane;
        u32x2* xo = XB ? (u32x2*)(XB + (size_t)row * D) + lane : nullptr;
#pragma unroll
        for (int j = 0; j < 8; ++j) {
            const f32x4 gg = ((const f32x4*)g)[lane + 64 * j], bb = ((const f32x4*)b)[lane + 64 * j];
            const f32x4 o = v[j] * rstd * gg + bb;
            ho[64 * j] = o;
            if (XB) { u32x2 w; w.x = cvt_pk_bf16(o[0], o[1]); w.y = cvt_pk_bf16(o[2], o[3]); xo[64 * j] = w; }
        }
    }
}

DI void final_ln_phase(const bf16_t* Y, const float* st, float* out, const float* g, const float* b) {
    const size_t gt = (size_t)blockIdx.x * 512 + threadIdx.x, NT = (size_t)gridDim.x * 512;
    for (size_t i = gt; i < (size_t)M * (D / 8); i += NT) {
        const size_t row = i >> 8; const int c8 = (int)(i & 255) * 8;
        const u32x4 y = *(const u32x4*)(Y + row * D + c8);
        float mu, rs; row_stats(st, (int)row, mu, rs);
        const f32x4 g0 = *(const f32x4*)(g + c8), g1 = *(const f32x4*)(g + c8 + 4), b0 = *(const f32x4*)(b + c8), b1 = *(const f32x4*)(b + c8 + 4);
        const f32x4 v0 = {bf_lo(y.x), bf_hi(y.x), bf_lo(y.y), bf_hi(y.y)}, v1 = {bf_lo(y.z), bf_hi(y.z), bf_lo(y.w), bf_hi(y.w)};
        *(f32x4*)(out + row * D + c8) = (v0 - mu) * rs * g0 + b0;
        *(f32x4*)(out + row * D + c8 + 4) = (v1 - mu) * rs * g1 + b1;
    }
}

DI void fixup_phase(bf16_t* GH, const float* FA, const float* FB, const float* cw, const float* cb) {
    constexpr int C4 = DFF / 4;
    for (int r0 = blockIdx.x * 4; r0 < 1024; r0 += gridDim.x * 4) {
        for (int c4 = threadIdx.x; c4 < C4; c4 += 512) {
            const int col = 4 * c4;
            const f32x4 w0 = *(const f32x4*)(cw + col), w1 = *(const f32x4*)(cw + DFF + col), w2 = *(const f32x4*)(cw + 2 * DFF + col), bb = *(const f32x4*)(cb + col);
            f32x4 am2[4], am1[4], a0[4], bv[4];
#pragma unroll
            for (int q = 0; q < 4; ++q) {
                const int ri = r0 + q, blk = ri >> 1, rr = ri & 1;
                const bool first = (blk & 63) == 0;
                const f32x4 z = {0.f, 0.f, 0.f, 0.f};
                if (rr == 0) {
                    am2[q] = first ? z : *(const f32x4*)(FA + (size_t)((blk - 1) * 4 + 0) * DFF + col);
                    am1[q] = first ? z : *(const f32x4*)(FA + (size_t)((blk - 1) * 4 + 1) * DFF + col);
                    a0[q] = *(const f32x4*)(FA + (size_t)(blk * 4 + 2) * DFF + col);
                    bv[q] = *(const f32x4*)(FB + (size_t)(blk * 2 + 0) * DFF + col);
                } else {
                    am2[q] = first ? z : *(const f32x4*)(FA + (size_t)((blk - 1) * 4 + 1) * DFF + col);
                    am1[q] = *(const f32x4*)(FA + (size_t)(blk * 4 + 2) * DFF + col);
                    a0[q] = *(const f32x4*)(FA + (size_t)(blk * 4 + 3) * DFF + col);
                    bv[q] = *(const f32x4*)(FB + (size_t)(blk * 2 + 1) * DFF + col);
                }
            }
#pragma unroll
            for (int q = 0; q < 4; ++q) {
                const int ri = r0 + q, blk = ri >> 1, rr = ri & 1;
                float o[4];
#pragma unroll
                for (int j = 0; j < 4; ++j) { const float cv = w2[j] * a0[q][j] + w1[j] * am1[q][j] + w0[j] * am2[q][j] + bb[j]; o[j] = silu_f(cv) * bv[q][j]; }
                u32x2 w; w.x = cvt_pk_bf16(o[0], o[1]); w.y = cvt_pk_bf16(o[2], o[3]);
                *(u32x2*)(GH + (size_t)(blk * 64 + rr) * DFF + col) = w;
            }
        }
    }
}

template <int NS>
DI void mma32u(f32x16& acc, const LAS unsigned char* A, int sa, const LAS unsigned char* Bt, int sb, int r, int h) {
    const LAS unsigned char* pa = A + r * sa + h * 16; const LAS unsigned char* pb = Bt + r * sb + h * 16;
    bf16x8 av[NS], bv[NS];
#pragma unroll
    for (int s = 0; s < NS; ++s) { av[s] = *(const LAS bf16x8*)(pa + s * 32); bv[s] = *(const LAS bf16x8*)(pb + s * 32); }
#pragma unroll
    for (int s = 0; s < NS; ++s) acc = __builtin_amdgcn_mfma_f32_32x32x16_bf16(av[s], bv[s], acc, 0, 0, 0);
}
DI int crow(int reg, int h) { return (reg & 3) + 8 * (reg >> 2) + 4 * h; }

namespace scan {
constexpr int QT = 0, KT = 17408, OF = 0, KTT = 34816, VT = 53248, PM = 71680, ST = 80896, CP = 115712, EL = 119808;
constexpr int S272 = 272, S144 = 144, SOF = 528;
}
DI void scan_phase(LAS unsigned char* lds, const bf16_t* Qb, const _Float16* LF, const bf16_t* Vb, const bf16_t* Gb, bf16_t* Ob, const float* norm_g, int item0, int istride) {
    using namespace scan;
    const int tid = threadIdx.x, lane = tid & 63, w = __builtin_amdgcn_readfirstlane(tid >> 6);
    const int r = lane & 31, h = lane >> 5;
    const int kp = lane, oct = w;
    const int e_row = tid >> 3, e_seg = tid & 7;
    for (int item = item0; item < BATCH * NHEAD; item += istride) {
        const int b = item >> 4, hd = item & 15, hc = hd * 128;
        const size_t rowbase = (size_t)b * SEQ;
        f32x16 sacc[2];
#pragma unroll
        for (int i = 0; i < 16; ++i) { sacc[0][i] = 0.f; sacc[1][i] = 0.f; }
        f32x2v lfv[8]; unsigned qv[8], vv[8]; u32x4 gtr[2];
        f32x4 ngr[4];
#pragma unroll
        for (int i = 0; i < 4; ++i) ngr[i] = *(const f32x4*)(norm_g + hc + 16 * e_seg + 4 * i);
        {
            const size_t e0 = (rowbase + 8 * oct) * D + hc + 2 * kp;
#pragma unroll
            for (int i = 0; i < 8; ++i) { { const h16x2 hv = *(const h16x2*)(LF + e0 + (size_t)i * D); lfv[i] = (f32x2v){(float)hv.x, (float)hv.y}; } qv[i] = *(const unsigned*)(Qb + e0 + (size_t)i * D); vv[i] = *(const unsigned*)(Vb + e0 + (size_t)i * D); }
        }
        for (int n = 0; n < SEQ / 64; ++n) {
            float cum0[8], cum1[8]; float c0 = 1.f, c1 = 1.f;
#pragma unroll
            for (int i = 0; i < 8; ++i) { c0 *= lfv[i].x; cum0[i] = c0; c1 *= lfv[i].y; cum1[i] = c1; }
            *(LAS f32x2v*)(lds + CP + (oct * 128 + 2 * kp) * 4) = (f32x2v){c0, c1};
            __syncthreads();
            float off0 = 1.f, off1 = 1.f;
            {
                f32x2v pp[7];
#pragma unroll
                for (int o = 0; o < 7; ++o) pp[o] = *(const LAS f32x2v*)(lds + CP + (o * 128 + 2 * kp) * 4);
#pragma unroll
                for (int o = 0; o < 7; ++o) { off0 *= (o < oct) ? pp[o].x : 1.f; off1 *= (o < oct) ? pp[o].y : 1.f; }
            }
            unsigned kt0[4], kt1[4], vt0[4], vt1[4];
#pragma unroll
            for (int i = 0; i < 8; i += 2) {
                float q0[2], q1[2], k0[2], k1[2];
#pragma unroll
                for (int d = 0; d < 2; ++d) {
                    const float E0 = cum0[i + d] * off0, E1 = cum1[i + d] * off1;
                    const float I0 = fminf(__builtin_amdgcn_rcpf(E0), 5.5e34f), I1 = fminf(__builtin_amdgcn_rcpf(E1), 5.5e34f);
                    const float kk0 = 1.0f - lfv[i + d].x, kk1 = 1.0f - lfv[i + d].y;
                    q0[d] = bf_lo(qv[i + d]) * E0; q1[d] = bf_hi(qv[i + d]) * E1; k0[d] = kk0 * I0; k1[d] = kk1 * I1;
                    const int t = 8 * oct + i + d;
                    *(LAS unsigned*)(lds + QT + t * S272 + 4 * kp) = cvt_pk_bf16(q0[d], q1[d]);
                    *(LAS unsigned*)(lds + KT + t * S272 + 4 * kp) = cvt_pk_bf16(k0[d], k1[d]);
                }
                kt0[i >> 1] = cvt_pk_bf16(k0[0], k0[1]); kt1[i >> 1] = cvt_pk_bf16(k1[0], k1[1]);
                vt0[i >> 1] = (vv[i] & 0xffffu) | (vv[i + 1] << 16); vt1[i >> 1] = (vv[i] >> 16) | (vv[i + 1] & 0xffff0000u);
            }
            *(LAS u32x4*)(lds + KTT + (2 * kp) * S144 + 16 * oct) = (u32x4){kt0[0], kt0[1], kt0[2], kt0[3]};
            *(LAS u32x4*)(lds + KTT + (2 * kp + 1) * S144 + 16 * oct) = (u32x4){kt1[0], kt1[1], kt1[2], kt1[3]};
            *(LAS u32x4*)(lds + VT + (2 * kp) * S144 + 16 * oct) = (u32x4){vt0[0], vt0[1], vt0[2], vt0[3]};
            *(LAS u32x4*)(lds + VT + (2 * kp + 1) * S144 + 16 * oct) = (u32x4){vt1[0], vt1[1], vt1[2], vt1[3]};
            if (oct == 7) *(LAS f32x2v*)(lds + EL + 8 * kp) = (f32x2v){cum0[7] * off0, cum1[7] * off1};
            __syncthreads();
            {
                const size_t ge = (rowbase + (size_t)n * 64 + e_row) * D + hc + 16 * e_seg;
                gtr[0] = *(const u32x4*)(Gb + ge); gtr[1] = *(const u32x4*)(Gb + ge + 8);
            }
            if (n + 1 < SEQ / 64) {
                const size_t e0 = (rowbase + (size_t)(n + 1) * 64 + 8 * oct) * D + hc + 2 * kp;
#pragma unroll
                for (int i = 0; i < 8; ++i) { { const h16x2 hv = *(const h16x2*)(LF + e0 + (size_t)i * D); lfv[i] = (f32x2v){(float)hv.x, (float)hv.y}; } qv[i] = *(const unsigned*)(Qb + e0 + (size_t)i * D); vv[i] = *(const unsigned*)(Vb + e0 + (size_t)i * D); }
            }
            const int tm = w >> 2, tn = w & 3;
            f32x16 oacc;
#pragma unroll
            for (int i = 0; i < 16; ++i) oacc[i] = 0.f;
            if (n > 0) mma32u<8>(oacc, lds + QT + 32 * tm * S272, S272, lds + ST + 32 * tn * S272, S272, r, h);
            if (w < 3) {
                const int pm = (w + 1) >> 1, pn = (w == 2) ? 1 : 0;
                f32x16 pacc;
#pragma unroll
                for (int i = 0; i < 16; ++i) pacc[i] = 0.f;
                mma32u<8>(pacc, lds + QT + 32 * pm * S272, S272, lds + KT + 32 * pn * S272, S272, r, h);
                const int scol = 32 * pn + r;
#pragma unroll
                for (int i = 0; i < 16; i += 1) {
                    const int trow = 32 * pm + crow(i, h);
                    const float val = (scol <= trow) ? pacc[i] : 0.f;
                    *(LAS unsigned short*)(lds + PM + trow * S144 + scol * 2) = (unsigned short)(cvt_pk_bf16(val, 0.f) & 0xffffu);
                }
            }
            __syncthreads();
            if (tm) mma32u<4>(oacc, lds + PM + 32 * tm * S144, S144, lds + VT + 32 * tn * S144, S144, r, h);
            else mma32u<2>(oacc, lds + PM + 32 * tm * S144, S144, lds + VT + 32 * tn * S144, S144, r, h);
#pragma unroll
            for (int i = 0; i < 16; ++i) *(LAS float*)(lds + OF + (32 * tm + crow(i, h)) * SOF + (32 * tn + r) * 4) = oacc[i];
#pragma unroll
            for (int i = 0; i < 2; ++i) {
                const int idx = 2 * w + i, km = idx >> 2, vn = idx & 3;
                mma32u<4>(sacc[i], lds + KTT + 32 * km * S144, S144, lds + VT + 32 * vn * S144, S144, r, h);
#pragma unroll
                for (int g = 0; g < 4; ++g) {
                    const f32x4 el = *(const LAS f32x4*)(lds + EL + (32 * km + 8 * g + 4 * h) * 4);
#pragma unroll
                    for (int j = 0; j < 4; ++j) sacc[i][4 * g + j] *= el[j];
                    u32x2 pk; pk.x = cvt_pk_bf16(sacc[i][4 * g], sacc[i][4 * g + 1]); pk.y = cvt_pk_bf16(sacc[i][4 * g + 2], sacc[i][4 * g + 3]);
                    *(LAS u32x2*)(lds + ST + (32 * vn + r) * S272 + (32 * km + 8 * g + 4 * h) * 2) = pk;
                }
            }
            __syncthreads();
            {
                const int trow = e_row, seg = e_seg;
                const size_t ge = (rowbase + (size_t)n * 64 + trow) * D + hc + 16 * seg;
                f32x4 o[4]; float ss = 0.f;
#pragma unroll
                for (int i = 0; i < 4; ++i) { o[i] = *(const LAS f32x4*)(lds + OF + trow * SOF + (16 * seg + 4 * i) * 4); ss += (o[i][0] * o[i][0] + o[i][1] * o[i][1]) + (o[i][2] * o[i][2] + o[i][3] * o[i][3]); }
                ss += __shfl_xor(ss, 1); ss += __shfl_xor(ss, 2); ss += __shfl_xor(ss, 4);
                const float rms = rsqrtf(ss * (1.0f / 128.0f) + RMS_EPS);
                const unsigned gw[8] = {gtr[0].x, gtr[0].y, gtr[0].z, gtr[0].w, gtr[1].x, gtr[1].y, gtr[1].z, gtr[1].w};
                unsigned ow[8];
#pragma unroll
                for (int i = 0; i < 4; ++i) {
                    const f32x4 ng = ngr[i];
                    const float y0 = o[i][0] * rms * ng[0] * bf_lo(gw[2 * i]), y1 = o[i][1] * rms * ng[1] * bf_hi(gw[2 * i]);
                    const float y2 = o[i][2] * rms * ng[2] * bf_lo(gw[2 * i + 1]), y3 = o[i][3] * rms * ng[3] * bf_hi(gw[2 * i + 1]);
                    ow[2 * i] = cvt_pk_bf16(y0, y1); ow[2 * i + 1] = cvt_pk_bf16(y2, y3);
                }
                *(u32x4*)(Ob + ge) = (u32x4){ow[0], ow[1], ow[2], ow[3]};
                *(u32x4*)(Ob + ge + 8) = (u32x4){ow[4], ow[5], ow[6], ow[7]};
            }
        }
        __syncthreads();
    }
}

namespace sgu { constexpr int WM = 0, VLT = 34816, GT = 69632, STAT = 137216, S272 = 272, SGT = 528; }
DI void spatial_phase(LAS unsigned char* lds, const bf16_t* U, bf16_t* Yout, const bf16_t* VV, const bf16_t* WSB, const float* bs, const float* lng, const float* lnb, const float* stv) {
    using namespace sgu;
    const int tid = threadIdx.x, lane = tid & 63, w = __builtin_amdgcn_readfirstlane(tid >> 6);
    const int r = lane & 31, h = lane >> 5;
    const int cp = lane, to = w;
    const int er = tid >> 4, ec = tid & 15;
    for (int item = blockIdx.x; item < M / 128; item += gridDim.x) {
        const size_t T0 = (size_t)item * 128;
        if (tid < 128) {
            const f32x2v sv = *(const f32x2v*)(stv + 2 * (T0 + tid));
            const float mean = sv.x * (1.0f / D); const float var = fmaxf(sv.y * (1.0f / D) - mean * mean, 0.f);
            *(LAS f32x2v*)(lds + STAT + tid * 8) = (f32x2v){mean, rsqrtf(var + LN_EPS)};
        }
        u32x4 wreg[4]; unsigned vreg[16]; u32x4 ureg[4];
        f32x2v lgr = *(const f32x2v*)(lng + 2 * cp), lbr = *(const f32x2v*)(lnb + 2 * cp);
        float btr[4];
#pragma unroll
        for (int i = 0; i < 4; ++i) btr[i] = bs[er + 32 * i];
#pragma unroll
        for (int i = 0; i < 4; ++i) { const int c = i * 512 + tid; wreg[i] = *(const u32x4*)(WSB + ((size_t)(c >> 4) * 128 + (c & 15) * 8)); }
#pragma unroll
        for (int i = 0; i < 16; ++i) vreg[i] = *(const unsigned*)(VV + (T0 + 16 * to + i) * D + 2 * cp);
#pragma unroll
        for (int i = 0; i < 4; ++i) ureg[i] = *(const u32x4*)(U + (T0 + er + 32 * i) * D + 8 * ec);
        __syncthreads();
        for (int g = 0; g < 16; ++g) {
#pragma unroll
            for (int i = 0; i < 4; ++i) { const int c = i * 512 + tid; *(LAS u32x4*)(lds + WM + (c >> 4) * S272 + (c & 15) * 16) = wreg[i]; }
            {
                const float g0 = lgr.x, g1 = lgr.y, b0 = lbr.x, b1 = lbr.y;
                unsigned a0[8], a1[8];
#pragma unroll
                for (int i = 0; i < 16; i += 2) {
                    float y0[2], y1[2];
#pragma unroll
                    for (int d = 0; d < 2; ++d) {
                        const f32x2v st = *(const LAS f32x2v*)(lds + STAT + (16 * to + i + d) * 8);
                        y0[d] = (bf_lo(vreg[i + d]) - st.x) * st.y * g0 + b0; y1[d] = (bf_hi(vreg[i + d]) - st.x) * st.y * g1 + b1;
                    }
                    a0[i >> 1] = cvt_pk_bf16(y0[0], y0[1]); a1[i >> 1] = cvt_pk_bf16(y1[0], y1[1]);
                }
                *(LAS u32x4*)(lds + VLT + (2 * cp) * S272 + 32 * to) = (u32x4){a0[0], a0[1], a0[2], a0[3]};
                *(LAS u32x4*)(lds + VLT + (2 * cp) * S272 + 32 * to + 16) = (u32x4){a0[4], a0[5], a0[6], a0[7]};
                *(LAS u32x4*)(lds + VLT + (2 * cp + 1) * S272 + 32 * to) = (u32x4){a1[0], a1[1], a1[2], a1[3]};
                *(LAS u32x4*)(lds + VLT + (2 * cp + 1) * S272 + 32 * to + 16) = (u32x4){a1[4], a1[5], a1[6], a1[7]};
            }
            __syncthreads();
            if (g + 1 < 16) {
#pragma unroll
                for (int i = 0; i < 4; ++i) { const int c = i * 512 + tid; wreg[i] = *(const u32x4*)(WSB + ((size_t)((g + 1) * 128 + (c >> 4)) * 128 + (c & 15) * 8)); }
#pragma unroll
                for (int i = 0; i < 16; ++i) vreg[i] = *(const unsigned*)(VV + (T0 + 16 * to + i) * D + (g + 1) * 128 + 2 * cp);
                lgr = *(const f32x2v*)(lng + (g + 1) * 128 + 2 * cp); lbr = *(const f32x2v*)(lnb + (g + 1) * 128 + 2 * cp);
            }
#pragma unroll
            for (int i = 0; i < 2; ++i) {
                const int tm = i ? 3 - (w >> 2) : (w >> 2), tn = w & 3;
                f32x16 acc;
#pragma unroll
                for (int q = 0; q < 16; ++q) acc[q] = 0.f;
                const LAS unsigned char* pa = lds + WM + 32 * tm * S272; const LAS unsigned char* pb = lds + VLT + 32 * tn * S272;
                if (tm == 0) mma32u<2>(acc, pa, S272, pb, S272, r, h);
                else if (tm == 1) mma32u<4>(acc, pa, S272, pb, S272, r, h);
                else if (tm == 2) mma32u<6>(acc, pa, S272, pb, S272, r, h);
                else mma32u<8>(acc, pa, S272, pb, S272, r, h);
#pragma unroll
                for (int q = 0; q < 16; ++q) *(LAS float*)(lds + GT + (32 * tm + crow(q, h)) * SGT + (32 * tn + r) * 4) = acc[q];
            }
            __syncthreads();
#pragma unroll
            for (int i = 0; i < 4; ++i) {
                const int t = er + 32 * i;
                const f32x4 g0 = *(const LAS f32x4*)(lds + GT + t * SGT + ec * 32), g1 = *(const LAS f32x4*)(lds + GT + t * SGT + ec * 32 + 16);
                const float bt = btr[i];
                const u32x4 uu = ureg[i];
                u32x4 o;
                o.x = cvt_pk_bf16(bf_lo(uu.x) * (g0[0] + bt), bf_hi(uu.x) * (g0[1] + bt)); o.y = cvt_pk_bf16(bf_lo(uu.y) * (g0[2] + bt), bf_hi(uu.y) * (g0[3] + bt));
                o.z = cvt_pk_bf16(bf_lo(uu.z) * (g1[0] + bt), bf_hi(uu.z) * (g1[1] + bt)); o.w = cvt_pk_bf16(bf_lo(uu.w) * (g1[2] + bt), bf_hi(uu.w) * (g1[3] + bt));
                *(u32x4*)(Yout + (T0 + t) * D + g * 128 + 8 * ec) = o;
            }
            if (g + 1 < 16) {
#pragma unroll
                for (int i = 0; i < 4; ++i) { ureg[i] = *(const u32x4*)(U + (T0 + er + 32 * i) * D + (g + 1) * 128 + 8 * ec); btr[i] = bs[(g + 1) * 128 + er + 32 * i]; }
            }
        }
        __syncthreads();
    }
}

__global__ void __launch_bounds__(512, 2) mk_fwd(Args a) {
    extern __shared__ __attribute__((aligned(16))) unsigned char lds_raw[];
    LAS unsigned char* lds = (LAS unsigned char*)lds_raw;
    unsigned char* const ws = a.ws;
    const int G = gridDim.x, c = blockIdx.x;
    const int lo = a.ph_lo, hi = a.ph_hi;
    if (threadIdx.x < 2) ((volatile LAS unsigned*)(lds + LDS_BARST))[threadIdx.x] = 0u;
    __syncthreads();
    const XcdBarrier xbar = xcd_barrier_post((unsigned*)TMP_(a, T_BAR), (volatile LAS unsigned*)(lds + LDS_BARST));
    if (lo < 0) cg::this_grid().sync();
#define IN(k) (lo <= (k) && (k) < hi)
#define SEAM(k) do { if (lo <= (k) && (k) + 1 < hi) xcd_barrier(xbar); } while (0)
#define XB_ ((bf16_t*)(ws + WS_XB))
#define H_ ((float*)(ws + WS_H))
#define ST_(i) ((float*)TMP_(a, T_STAT + (size_t)(i) * M * 8))
#define ST3_ ((float*)(ws + WS_ST3))
    if (IN(0)) prologue_phase(a, lds);
    SEAM(0);
    if (IN(1)) {
        pg8::Gemm g{XB_, (const bf16_t*)(ws + WS_W_HGIN), M, HG_N, D}; pg8::StaticOrder S; S.init(M, HG_N, G, c);
        EpiHgProj E{ws, (const float*)TMP_(a, T_LB)};
        pg8::gemm_phase<EpiHgProj, pg8::StaticOrder, true, true>(lds, g, S, E);
    }
    SEAM(1);
    if (IN(2)) {
        const int NS = BATCH * NHEAD;
        if (G >= 2 * NS) {
            if (c < NS) scan_phase(lds, (const bf16_t*)(ws + WS_Q), (const _Float16*)(ws + WS_LF), (const bf16_t*)(ws + WS_V), (const bf16_t*)(ws + WS_GT), (bf16_t*)(ws + WS_Q), a.in[3], c, NS);
            else { convert_rest(a, lds, (c - NS) * 8 + (int)(threadIdx.x >> 6), (G - NS) * 8); wsb_phase(a, (size_t)(c - NS) * 512 + threadIdx.x, (size_t)(G - NS) * 512); }
        } else {
            scan_phase(lds, (const bf16_t*)(ws + WS_Q), (const _Float16*)(ws + WS_LF), (const bf16_t*)(ws + WS_V), (const bf16_t*)(ws + WS_GT), (bf16_t*)(ws + WS_Q), a.in[3], c, G);
            __syncthreads();
            convert_rest(a, lds, c * 8 + (int)(threadIdx.x >> 6), G * 8); wsb_phase(a, (size_t)c * 512 + threadIdx.x, (size_t)G * 512);
        }
    }
    SEAM(2);
    if (IN(3)) {
        pg8::Gemm g{(const bf16_t*)(ws + WS_Q), (const bf16_t*)(ws + WS_W_HGOUT), M, D, D}; pg8::StaticOrder S; S.init(M, D, G, c);
        EpiRes<0, false> E{a.in[0], H_, XB_, nullptr, ST_(0), nullptr, nullptr};
        pg8::gemm_phase<EpiRes<0, false>, pg8::StaticOrder, true, true>(lds, g, S, E);
    }
    SEAM(3);
#define FFN_PHASES(P, layer, si, so, LASTF) \
    if (IN(P)) { \
        pg8::Gemm g{XB_, (const bf16_t*)(ws + ((layer) ? WS_W_UP1 : WS_W_UP0)), M, UP_N, D}; pg8::StaticOrder S; S.init(M, UP_N, G, c); \
        EpiUp E{(bf16_t*)(ws + WS_GH), (float*)(ws + WS_FA), (float*)(ws + WS_FB), a.in[12] + (size_t)(layer) * 3 * DFF, a.in[13] + (size_t)(layer) * DFF, ST_(si), (const float*)TMP_(a, (layer) ? T_CS_UP1 : T_CS_UP0)}; \
        pg8::gemm_phase<EpiUp, pg8::StaticOrder, true, true>(lds, g, S, E); \
    } \
    SEAM(P); \
    if (IN(P + 1)) fixup_phase((bf16_t*)(ws + WS_GH), (const float*)(ws + WS_FA), (const float*)(ws + WS_FB), a.in[12] + (size_t)(layer) * 3 * DFF, a.in[13] + (size_t)(layer) * DFF); \
    SEAM(P + 1); \
    if (IN(P + 2)) { \
        pg8::Gemm g{(const bf16_t*)(ws + WS_GH), (const bf16_t*)(ws + ((layer) ? WS_W_DN1 : WS_W_DN0)), M, D, DFF}; pg8::StaticOrder S; S.init(M, D, G, c); \
        EpiRes<1, LASTF> E{H_, H_, XB_, ST_(si), ((so) == 3 ? ST3_ : ST_(so)), a.in[15] + (layer) * D, a.in[16] + (layer) * D}; \
        pg8::gemm_phase<EpiRes<1, LASTF>, pg8::StaticOrder, true, true>(lds, g, S, E); \
    } \
    SEAM(P + 2);
    FFN_PHASES(4, 0, 0, 1, false)
    if (IN(7)) {
        pg8::Gemm g{XB_, (const bf16_t*)(ws + WS_W_SGIN), M, SG_N, D}; pg8::StaticOrder S; S.init(M, SG_N, G, c);
        EpiGelu E{(bf16_t*)(ws + WS_U), (bf16_t*)(ws + WS_VV), ST_(1), (const float*)TMP_(a, T_CS_SGIN), (float*)TMP_(a, T_STATV)};
        pg8::gemm_phase<EpiGelu, pg8::StaticOrder, true, true>(lds, g, S, E);
    }
    SEAM(7);
    if (IN(8)) spatial_phase(lds, (const bf16_t*)(ws + WS_U), (bf16_t*)(ws + WS_U), (const bf16_t*)(ws + WS_VV), (const bf16_t*)TMP_(a, T_WSB), a.in[9], a.in[6], a.in[7], (const float*)TMP_(a, T_STATV));
    SEAM(8);
    if (IN(9)) {
        pg8::Gemm g{(const bf16_t*)(ws + WS_U), (const bf16_t*)(ws + WS_W_SGOUT), M, D, D}; pg8::StaticOrder S; S.init(M, D, G, c);
        EpiRes<1, false> E{H_, H_, XB_, ST_(1), ST_(2), a.in[17], a.in[18]};
        pg8::gemm_phase<EpiRes<1, false>, pg8::StaticOrder, true, true>(lds, g, S, E);
    }
    SEAM(9);
    FFN_PHASES(10, 1, 2, 3, false)
    if (IN(13)) final_ln_phase(XB_, ST3_, a.out, a.in[17] + D, a.in[18] + D);
#undef IN
#undef SEAM
}

extern "C" void kernel_launch(void* const* d_in, const int* in_sizes, int n_in, void* d_out, int out_size, void* d_ws, size_t ws_size, hipStream_t stream) {
    static int grid = 0;
    if (grid == 0) {
        if (n_in != 19 || in_sizes[0] != M * D || out_size != M * D || ws_size < WS_NEED) {
            fprintf(stderr, "kernel_launch: unexpected problem: n_in %d in0 %d out %d ws %zu (need %zu)\n", n_in, n_in > 0 ? in_sizes[0] : -1, out_size, ws_size, (size_t)WS_NEED);
            grid = -1; return;
        }
        int dev = 0, cus = 0, per_cu = 0;
        hipGetDevice(&dev); hipDeviceGetAttribute(&cus, hipDeviceAttributeMultiprocessorCount, dev);
        hipFuncSetAttribute((const void*)mk_fwd, hipFuncAttributeMaxDynamicSharedMemorySize, LDS_BYTES);
        hipOccupancyMaxActiveBlocksPerMultiprocessor(&per_cu, (const void*)mk_fwd, 512, LDS_BYTES);
        if (per_cu < 1) per_cu = 1;
        grid = cus * per_cu;
        (void)hipGetLastError();
    }
    if (grid < 0) return;
    Args a{};
    for (int i = 0; i < 19; ++i) a.in[i] = (const float*)d_in[i];
    a.out = (float*)d_out; a.ws = (unsigned char*)d_ws;
    (void)hipMemsetAsync((unsigned char*)d_out + T_BAR, 0, XCD_BAR_WORDS * 4, stream);
    a.ph_lo = 0; a.ph_hi = NPHASE;
    void* args[] = {&a};
    hipError_t e = hipLaunchCooperativeKernel((const void*)mk_fwd, dim3(grid), dim3(512), args, LDS_BYTES, stream);
    if (e != hipSuccess) fprintf(stderr, "cooperative launch failed: %s (grid %d)\n", hipGetErrorString(e), grid);
}
```
